# Optimizing an MI355X kernel written in HIP

```python
import jax, jax.numpy as jnp
from jax import lax
import numpy as np

D_MODEL = 1024
BATCH = 4
SEQ = 8192
DEPTH = 4

GRID_W = 64
CTX_LEN = 256
EPS = 1e-6
SSD_HEADS = 8
SSD_HEAD_DIM = 64
SSD_INNER = SSD_HEADS * SSD_HEAD_DIM
SSD_GROUPS = 2
SSD_STATE = 64
SSD_CONV = 5
SSD_CHUNK = 128
SSD_XBC = SSD_INNER + 2 * SSD_GROUPS * SSD_STATE
POOL_WINDOWS = (2, 4, 8, 16)
POOL_WIDTH = 512
POOL_GROUP = POOL_WIDTH // len(POOL_WINDOWS)
RET_HEADS = 8
RET_QK_DIM = 64
RET_V_DIM = 64
RET_QK_WIDTH = RET_HEADS * RET_QK_DIM
RET_WIDTH = RET_HEADS * RET_V_DIM
RET_CHUNK = 128
ROPE_BASE = 10000.0
N_BRANCH = 3
BRANCH_WIDTH = 512
COL_Z = 0
COL_XBC = COL_Z + SSD_INNER
COL_DT = COL_XBC + SSD_XBC
COL_POOL = COL_DT + 2 * SSD_HEADS
COL_Q = COL_POOL + POOL_WIDTH
COL_K = COL_Q + RET_QK_WIDTH
COL_V = COL_K + RET_QK_WIDTH
COL_G = COL_V + RET_WIDTH
COL_GATE = COL_G + RET_WIDTH
IN_COLS = COL_GATE + N_BRANCH * D_MODEL
D_FF = 2816
N_EXPERTS = 8
TOP_K = 2
EXPERT_FF = 3584
MOE_BLOCK = 256
N_DENSE = (DEPTH + 1) // 2
N_MOE = DEPTH // 2

kernel_name = 'hybrid_ssd_pool_retention_moe_dit'


def rmsnorm(x, g):
    xf = x.astype(jnp.float32)
    y = xf * lax.rsqrt(jnp.mean(xf * xf, axis=-1, keepdims=True) + EPS)
    return (y * g.astype(jnp.float32)).astype(x.dtype)


def adaln(cvec, w, b):
    m = jax.nn.silu(cvec) @ w + b
    return jnp.split(m[:, None, :], 6, axis=-1)


def modulate(h, shift, scale):
    return h * (1 + scale) + shift


def flip(a):
    return jnp.flip(a, axis=1)


def centred_dwconv(u, w, bias):
    ch = u.shape[-1]
    pad = w.shape[0] // 2
    y = lax.conv_general_dilated(u, w[:, None, :].astype(u.dtype), window_strides=(1,),
                                 padding=[(pad, pad)], dimension_numbers=('NWC', 'WIO', 'NWC'),
                                 feature_group_count=ch)
    return y + bias


def ssd_chunk_scan(xdt, da, bm, cm, s0):
    b, l, h, p = xdt.shape
    n = bm.shape[-1]
    q = SSD_CHUNK
    nc = l // q
    X = xdt.reshape(b, nc, q, h, p)
    Bc = bm.reshape(b, nc, q, h, n)
    Cc = cm.reshape(b, nc, q, h, n)
    A = da.astype(jnp.float32).reshape(b, nc, q, h).transpose(0, 3, 1, 2)
    acs = jnp.cumsum(A, axis=-1)
    causal = jnp.tril(jnp.ones((q, q), dtype=bool))
    seg = acs[..., :, None] - acs[..., None, :]
    Lm = jnp.exp(jnp.where(causal, seg, -jnp.inf))
    scores = jnp.einsum('bclhn,bcshn->bhcls', Cc, Bc) * Lm
    y_diag = jnp.einsum('bhcls,bcshp->bclhp', scores, X)
    decay_states = jnp.exp(acs[..., -1:] - acs)
    states = jnp.einsum('bclhn,bhcl,bclhp->bchpn', Bc, decay_states, X)
    chunk_decay = jnp.exp(acs[..., -1])

    def step(s, inp):
        st, dec = inp
        return dec[:, :, None, None] * s + st, s

    s_fin, prev = lax.scan(step, s0, (states.transpose(1, 0, 2, 3, 4), chunk_decay.transpose(2, 0, 1)))
    prev = prev.transpose(1, 0, 2, 3, 4)
    y_off = jnp.einsum('bclhn,bchpn,bhcl->bclhp', Cc, prev, jnp.exp(acs))
    return (y_diag + y_off).reshape(b, l, h, p), s_fin


def retention_chunk_scan(q, k, v, log_gamma, s0):
    b, l, h, dk = q.shape
    dv = v.shape[-1]
    Q = RET_CHUNK
    nc = l // Q
    qc = q.reshape(b, nc, Q, h, dk)
    kc = k.reshape(b, nc, Q, h, dk)
    vc = v.reshape(b, nc, Q, h, dv)
    idx = jnp.arange(Q, dtype=jnp.float32)
    diff = idx[:, None] - idx[None, :]
    dmat = jnp.where(diff >= 0, jnp.exp(log_gamma[:, None, None] * jnp.maximum(diff, 0.0)), 0.0)
    inner = jnp.einsum('bcihd,bcmhd->bchim', qc, kc) * dmat
    y_in = jnp.einsum('bchim,bcmhe->bcihe', inner, vc)
    k_dec = jnp.exp(log_gamma[:, None] * (Q - 1 - idx)[None, :])
    kv = jnp.einsum('bcmhd,hm,bcmhe->bchde', kc, k_dec, vc)
    chunk_dec = jnp.exp(log_gamma * Q)

    def step(s, kv_c):
        return chunk_dec[None, :, None, None] * s + kv_c, s

    s_fin, prev = lax.scan(step, s0, kv.transpose(1, 0, 2, 3, 4))
    prev = prev.transpose(1, 0, 2, 3, 4)
    q_dec = jnp.exp(log_gamma[:, None] * (idx + 1)[None, :])
    y_x = jnp.einsum('bcihd,bchde,hi->bcihe', qc, prev, q_dec)
    return (y_in + y_x).reshape(b, l, h, dv), s_fin


def axial_rope(x, row, col):
    n_pair = x.shape[-1] // 2
    n_axis = n_pair // 2
    inv = ROPE_BASE ** (-jnp.arange(n_axis, dtype=jnp.float32) / n_axis)
    ang = jnp.concatenate([row[:, None] * inv, col[:, None] * inv], axis=-1)[None, :, None, :]
    cos, sin = jnp.cos(ang), jnp.sin(ang)
    x1, x2 = x[..., :n_pair], x[..., n_pair:]
    return jnp.concatenate([x1 * cos - x2 * sin, x1 * sin + x2 * cos], axis=-1)


def head_groupnorm(y):
    y = y.astype(jnp.float32)
    mu = jnp.mean(y, axis=-1, keepdims=True)
    var = jnp.mean(jnp.square(y - mu), axis=-1, keepdims=True)
    return (y - mu) * lax.rsqrt(var + EPS)


def ssd_branch(pc, pl, conv_w, conv_b, dt_bias, a_log, d_skip, norm_g, need_ctx):
    f32 = jnp.float32
    gn = SSD_GROUPS * SSD_STATE
    rep = SSD_HEADS // SSD_GROUPS

    def prep(p):
        b, l = p.shape[:2]
        z = p[..., COL_Z:COL_Z + SSD_INNER]
        xbc = jax.nn.silu(centred_dwconv(p[..., COL_XBC:COL_XBC + SSD_XBC], conv_w, conv_b))
        xs = xbc[..., :SSD_INNER].reshape(b, l, SSD_HEADS, SSD_HEAD_DIM)
        bm = jnp.repeat(xbc[..., SSD_INNER:SSD_INNER + gn].reshape(b, l, SSD_GROUPS, SSD_STATE), rep, axis=2)
        cm = jnp.repeat(xbc[..., SSD_INNER + gn:].reshape(b, l, SSD_GROUPS, SSD_STATE), rep, axis=2)
        dt_raw = p[..., COL_DT:COL_DT + 2 * SSD_HEADS].astype(f32)
        return z, xs, bm, cm, dt_raw

    def direction(xs, dt_raw, d):
        dt = jax.nn.softplus(dt_raw[..., d * SSD_HEADS:(d + 1) * SSD_HEADS] + dt_bias[d].astype(f32))
        da = dt * (-jnp.exp(a_log[d].astype(f32)))
        return xs * dt[..., None], da

    zc, xc, bc, cc, dtc = prep(pc)
    zl, xl, bl, cl, dtl = prep(pl)
    s0 = jnp.zeros((pc.shape[0], SSD_HEADS, SSD_HEAD_DIM, SSD_STATE), f32)
    u_c, a_c = direction(xc, dtc, 0)
    u_l, a_l = direction(xl, dtl, 0)
    yc_f, sc_f = ssd_chunk_scan(u_c, a_c, bc, cc, s0)
    yl_f, _ = ssd_chunk_scan(u_l, a_l, bl, cl, sc_f)
    u_c, a_c = direction(xc, dtc, 1)
    u_l, a_l = direction(xl, dtl, 1)
    yc_b, sc_b = ssd_chunk_scan(flip(u_c), flip(a_c), flip(bc), flip(cc), s0)
    yl_b, _ = ssd_chunk_scan(flip(u_l), flip(a_l), flip(bl), flip(cl), sc_b)

    def finish(y_f, y_b, xs, z):
        b, l = xs.shape[:2]
        y = y_f + flip(y_b) + d_skip.astype(f32)[:, None] * xs
        return rmsnorm(y.reshape(b, l, SSD_INNER) * jax.nn.silu(z.astype(f32)), norm_g)

    out_l = finish(yl_f, yl_b, xl, zl)
    out_c = finish(yc_f, yc_b, xc, zc) if need_ctx else None
    return out_c, out_l


def centred_window_mean(u, w):
    b, l, ch = u.shape
    left = w // 2
    right = w - 1 - left
    cs = jnp.concatenate([jnp.zeros((b, 1, ch), jnp.float32), jnp.cumsum(u.astype(jnp.float32), axis=1)], axis=1)
    t = jnp.arange(l)
    lo = jnp.maximum(t - left, 0)
    hi = jnp.minimum(t + right, l - 1) + 1
    s = jnp.take(cs, hi, axis=1) - jnp.take(cs, lo, axis=1)
    return s / (hi - lo).astype(jnp.float32)[None, :, None]


def pool_branch(p, pool_w, pool_scale):
    u = p[..., COL_POOL:COL_POOL + POOL_WIDTH]
    outs = []
    for gi, w in enumerate(POOL_WINDOWS):
        ug = u[..., gi * POOL_GROUP:(gi + 1) * POOL_GROUP]
        mixed = centred_window_mean(ug, w) - ug.astype(jnp.float32)
        outs.append(mixed @ pool_w[gi])
    return jnp.concatenate(outs, axis=-1) * pool_scale


def retention_branch(pc, pl, decay_logit, row, col, need_ctx):
    f32 = jnp.float32
    log_gamma = jax.nn.log_sigmoid(decay_logit.astype(f32))

    def split(p):
        b, l = p.shape[:2]
        q = p[..., COL_Q:COL_Q + RET_QK_WIDTH].reshape(b, l, RET_HEADS, RET_QK_DIM)
        k = p[..., COL_K:COL_K + RET_QK_WIDTH].reshape(b, l, RET_HEADS, RET_QK_DIM) * (RET_QK_DIM ** -0.5)
        v = p[..., COL_V:COL_V + RET_WIDTH].reshape(b, l, RET_HEADS, RET_V_DIM)
        g = p[..., COL_G:COL_G + RET_WIDTH]
        return q, k, v, g

    qc, kc, vc, gc = split(pc)
    ql, kl, vl, gl = split(pl)
    ql = axial_rope(ql, row, col)
    kl = axial_rope(kl, row, col)
    s0 = jnp.zeros((pc.shape[0], RET_HEADS, RET_QK_DIM, RET_V_DIM), f32)
    yc_f, sf = retention_chunk_scan(qc, kc, vc, log_gamma[0], s0)
    yl_f, _ = retention_chunk_scan(ql, kl, vl, log_gamma[0], sf)
    yc_b, sb = retention_chunk_scan(flip(qc), flip(kc), flip(vc), log_gamma[1], s0)
    yl_b, _ = retention_chunk_scan(flip(ql), flip(kl), flip(vl), log_gamma[1], sb)

    def finish(y, g):
        b, l = y.shape[:2]
        return head_groupnorm(y).reshape(b, l, RET_WIDTH) * jax.nn.silu(g.astype(f32))

    out_l = finish(yl_f + flip(yl_b), gl)
    out_c = finish(yc_f + flip(yc_b), gc) if need_ctx else None
    return out_c, out_l


def merge_branches(p, branches, w_branch, w_out):
    b, l = p.shape[:2]
    gates = jax.nn.sigmoid(p[..., COL_GATE:COL_GATE + N_BRANCH * D_MODEL].astype(jnp.float32))
    gates = gates.reshape(b, l, N_BRANCH, D_MODEL)
    acc = 0.0
    for i, br in enumerate(branches):
        acc = acc + gates[:, :, i, :] * (br @ w_branch[i]).astype(jnp.float32)
    return acc.astype(p.dtype) @ w_out


def token_mixer(hc, hl, w_in, conv_w, conv_b, dt_bias, a_log, d_skip, ssd_norm_g, pool_w, pool_scale,
                ret_decay_logit, w_branch, w_out, row, col, need_ctx):
    pc = hc @ w_in
    pl = hl @ w_in
    sc, sl = ssd_branch(pc, pl, conv_w, conv_b, dt_bias, a_log, d_skip, ssd_norm_g, need_ctx)
    rc, rl = retention_branch(pc, pl, ret_decay_logit, row, col, need_ctx)
    out_l = merge_branches(pl, (sl, pool_branch(pl, pool_w, pool_scale), rl), w_branch, w_out)
    out_c = merge_branches(pc, (sc, pool_branch(pc, pool_w, pool_scale), rc), w_branch, w_out) if need_ctx else None
    return out_c, out_l


def swiglu(h, w13, w2):
    g, u = jnp.split(h @ w13, 2, axis=-1)
    return (jax.nn.silu(g) * u) @ w2


def moe_swiglu(h, w_router, w13, w2):
    n, d = h.shape
    logits = (h @ w_router).astype(jnp.float32)
    top_v, top_i = lax.top_k(logits, TOP_K)
    top_w = jax.nn.softmax(top_v, axis=-1)
    n_slots = n * TOP_K
    e_flat = top_i.reshape(-1)
    w_flat = top_w.reshape(-1)
    tok_flat = jnp.repeat(jnp.arange(n, dtype=jnp.int32), TOP_K)
    order = jnp.argsort(e_flat)
    e_sorted = e_flat[order]
    tok_sorted = tok_flat[order]
    w_sorted = w_flat[order]
    counts = jnp.bincount(e_flat, length=N_EXPERTS)
    starts = jnp.cumsum(counts) - counts
    padded = (counts + MOE_BLOCK - 1) // MOE_BLOCK * MOE_BLOCK
    pad_ends = jnp.cumsum(padded)
    pad_starts = pad_ends - padded
    dest = pad_starts[e_sorted] + jnp.arange(n_slots) - starts[e_sorted]
    n_blocks = -(-(n_slots + N_EXPERTS * (MOE_BLOCK - 1)) // MOE_BLOCK)
    cap = n_blocks * MOE_BLOCK
    buf_tok = jnp.zeros((cap,), jnp.int32).at[dest].set(tok_sorted)
    buf_w = jnp.zeros((cap,), jnp.float32).at[dest].set(w_sorted)
    block_e = jnp.minimum(jnp.searchsorted(pad_ends, jnp.arange(n_blocks) * MOE_BLOCK, side='right'), N_EXPERTS - 1)
    xb = h[buf_tok].reshape(n_blocks, MOE_BLOCK, d)

    def run_block(args):
        xblk, e = args
        g, u = jnp.split(xblk @ w13[e], 2, axis=-1)
        return (jax.nn.silu(g) * u) @ w2[e]

    yb = lax.map(run_block, (xb, block_e)).reshape(cap, d).astype(jnp.float32)
    y = jnp.zeros((n, d), jnp.float32).at[buf_tok].add(yb * buf_w[:, None])
    return y.astype(h.dtype)


def setup_inputs(seed: int = 0) -> dict:
    key = jax.random.key(seed)
    ks = jax.random.split(key, 32)
    nrm = jax.random.normal
    D = D_MODEL
    dt = jnp.exp(jax.random.uniform(ks[10], (DEPTH, 2, SSD_HEADS)) * (np.log(0.1) - np.log(0.001)) + np.log(0.001))
    gamma_exp = 5.0 + jnp.arange(RET_HEADS, dtype=jnp.float32)
    ret_logit = jnp.log(2.0 ** gamma_exp - 1.0)
    return {
        'x': nrm(ks[0], (BATCH, SEQ, D), jnp.float32),
        'c': nrm(ks[1], (BATCH, D), jnp.float32),
        'ctx': nrm(ks[2], (BATCH, CTX_LEN, D), jnp.float32),
        'c_ctx': nrm(ks[3], (D,), jnp.float32),
        'ada_w': nrm(ks[4], (DEPTH, D, 6 * D), jnp.float32) * (0.5 * D ** -0.5),
        'ada_b': nrm(ks[5], (DEPTH, 6 * D), jnp.float32) * 0.02,
        'norm1_g': 1.0 + 0.02 * nrm(ks[6], (DEPTH, D), jnp.float32),
        'norm2_g': 1.0 + 0.02 * nrm(ks[7], (DEPTH, D), jnp.float32),
        'w_in': nrm(ks[8], (DEPTH, D, IN_COLS), jnp.float32) * D ** -0.5,
        'ssd_conv_w': nrm(ks[9], (DEPTH, SSD_CONV, SSD_XBC), jnp.float32) * SSD_CONV ** -0.5,
        'ssd_conv_b': nrm(ks[11], (DEPTH, SSD_XBC), jnp.float32) * 0.02,
        'ssd_dt_bias': dt + jnp.log(-jnp.expm1(-dt)),
        'ssd_a_log': jnp.log(jax.random.uniform(ks[12], (DEPTH, 2, SSD_HEADS), minval=1.0, maxval=16.0)),
        'ssd_d': 1.0 + 0.02 * nrm(ks[13], (DEPTH, SSD_HEADS), jnp.float32),
        'ssd_norm_g': 1.0 + 0.02 * nrm(ks[14], (DEPTH, SSD_INNER), jnp.float32),
        'pool_w': nrm(ks[15], (DEPTH, len(POOL_WINDOWS), POOL_GROUP, POOL_GROUP), jnp.float32) * POOL_GROUP ** -0.5,
        'pool_scale': 1.0 + 0.02 * nrm(ks[16], (DEPTH, POOL_WIDTH), jnp.float32),
        'ret_decay_logit': ret_logit[None, None, :] + 0.01 * nrm(ks[17], (DEPTH, 2, RET_HEADS), jnp.float32),
        'w_branch': nrm(ks[18], (DEPTH, N_BRANCH, BRANCH_WIDTH, D), jnp.float32) * BRANCH_WIDTH ** -0.5,
        'w_out': nrm(ks[19], (DEPTH, D, D), jnp.float32) * D ** -0.5,
        'ffn_w13': nrm(ks[20], (N_DENSE, D, 2 * D_FF), jnp.float32) * D ** -0.5,
        'ffn_w2': nrm(ks[21], (N_DENSE, D_FF, D), jnp.float32) * D_FF ** -0.5,
        'moe_router': nrm(ks[22], (N_MOE, D, N_EXPERTS), jnp.float32) * D ** -0.5,
        'moe_w13': nrm(ks[23], (N_MOE, N_EXPERTS, D, 2 * EXPERT_FF), jnp.float32) * D ** -0.5,
        'moe_w2': nrm(ks[24], (N_MOE, N_EXPERTS, EXPERT_FF, D), jnp.float32) * EXPERT_FF ** -0.5,
        'final_norm_g': 1.0 + 0.02 * nrm(ks[25], (D,), jnp.float32),
    }


def reference(x, c, ctx, c_ctx, ada_w, ada_b, norm1_g, norm2_g, w_in, ssd_conv_w, ssd_conv_b, ssd_dt_bias,
              ssd_a_log, ssd_d, ssd_norm_g, pool_w, pool_scale, ret_decay_logit, w_branch, w_out,
              ffn_w13, ffn_w2, moe_router, moe_w13, moe_w2, final_norm_g):
    f32 = jnp.float32
    b, seq = x.shape[0], x.shape[1]
    rows = seq // GRID_W
    row = jnp.repeat(jnp.arange(rows, dtype=f32), GRID_W)
    col = (jnp.arange(rows * GRID_W) % GRID_W).astype(f32)
    h_ctx = ctx
    for layer in range(DEPTH):
        need_ctx = layer < DEPTH - 1
        sh1, sc1, g1, sh2, sc2, g2 = adaln(c, ada_w[layer], ada_b[layer])
        csh1, csc1, cg1, csh2, csc2, cg2 = adaln(c_ctx[None, :], ada_w[layer], ada_b[layer])
        hl = modulate(rmsnorm(x, norm1_g[layer]), sh1, sc1)
        hc = modulate(rmsnorm(h_ctx, norm1_g[layer]), csh1, csc1)
        mc, ml = token_mixer(hc, hl, w_in[layer], ssd_conv_w[layer], ssd_conv_b[layer], ssd_dt_bias[layer],
                             ssd_a_log[layer], ssd_d[layer], ssd_norm_g[layer], pool_w[layer], pool_scale[layer],
                             ret_decay_logit[layer], w_branch[layer], w_out[layer], row, col, need_ctx)
        x = x + (g1 * ml).astype(x.dtype)
        if need_ctx:
            h_ctx = h_ctx + (cg1 * mc).astype(h_ctx.dtype)
        tok = modulate(rmsnorm(x, norm2_g[layer]), sh2, sc2).reshape(-1, D_MODEL)
        if need_ctx:
            fc = modulate(rmsnorm(h_ctx, norm2_g[layer]), csh2, csc2)
            tok = jnp.concatenate([fc.reshape(-1, D_MODEL), tok], axis=0)
        if layer % 2 == 0:
            y = swiglu(tok, ffn_w13[layer // 2], ffn_w2[layer // 2])
        else:
            y = moe_swiglu(tok, moe_router[layer // 2], moe_w13[layer // 2], moe_w2[layer // 2])
        n_ctx_tok = tok.shape[0] - b * seq
        x = x + (g2 * y[n_ctx_tok:].reshape(x.shape)).astype(x.dtype)
        if need_ctx:
            h_ctx = h_ctx + (cg2 * y[:n_ctx_tok].reshape(h_ctx.shape)).astype(h_ctx.dtype)
    return rmsnorm(x, final_norm_g)
```

```cpp
#include <hip/hip_runtime.h>
#include <cstdio>
#include <cstdint>
namespace pg8 {
#define PG8_LAS __attribute__((address_space(3)))
#define PG8_G __attribute__((address_space(1)))
typedef unsigned short bf16_t;
typedef short bf16x8 __attribute__((ext_vector_type(8)));
typedef float f32x4 __attribute__((ext_vector_type(4)));
typedef unsigned u32x4 __attribute__((ext_vector_type(4)));
typedef int i32x4 __attribute__((ext_vector_type(4)));
typedef int i32x8 __attribute__((ext_vector_type(8)));
constexpr int P_STRIDE = 7296;
constexpr int BM = 256, BK = 64, HALF = 128, HTB = HALF * BK * 2  , STAGE_BYTES = 8 * HTB, NXCD = 8, WGM = 4;

__host__ __device__ __forceinline__ int lds_byte(int r, int c) { const int st = (r >> 4) * 2 + (c >> 5), rr = r & 15, cc = c & 31, ob = rr * 64 + cc * 2; return st * 1024 + (ob ^ (((ob >> 9) & 1) << 5)); }
__host__ __device__ __forceinline__ void stage_rc(int b, int& R, int& C) { const int st = b / 1024, sb = b % 1024, swz = sb ^ (((sb >> 9) & 1) << 5); R = (st >> 1) * 16 + swz / 64; C = (st & 1) * 32 + (swz % 64) / 2; }
__host__ __device__ __forceinline__ int perm32(int rho) { const int n = rho >> 4, i = rho & 15; return 8 * (i >> 2) + 4 * n + (i & 3); }

struct Unit { int pm, pn; };
struct Gemm { const bf16_t* A; const bf16_t* Bt; int M, N, K; };

struct StaticOrder {
    int nM, nN, nwg, G, c, pm0;
    __host__ __device__ void init(int M, int N, int G_, int c_, int pm0_ = 0) { nM = M / BM; nN = N / BM; nwg = nM * nN; G = G_; c = c_; pm0 = pm0_; }
    __host__ __device__ bool next(int i, Unit& u) const {
        const long L = (long)i * G + c; if (L >= nwg) return false;
        int wgid = (int)L; { const int q = nwg / NXCD, r = nwg % NXCD, xcd = wgid % NXCD, off = wgid / NXCD; wgid = (xcd < r ? xcd * (q + 1) : r * (q + 1) + (xcd - r) * q) + off; }
        const int nig = WGM * nN, gid = wgid / nig, fm = gid * WGM, gsz = (nM - fm) < WGM ? (nM - fm) : WGM;
        u.pm = pm0 + fm + ((wgid % nig) % gsz); u.pn = (wgid % nig) / gsz; return true;
    }
    __device__ __forceinline__ void a_ready(const Unit&) const {}
    __device__ __forceinline__ void done(const Unit&) const {}
};

__device__ __forceinline__ unsigned cvt_pk_bf16(float lo, float hi) { unsigned r; asm volatile("v_cvt_pk_bf16_f32 %0, %1, %2" : "=v"(r) : "v"(lo), "v"(hi)); return r; }
typedef unsigned u32x2 __attribute__((ext_vector_type(2)));
__device__ __forceinline__ float silu_f(float x) { return x * __builtin_amdgcn_rcpf(1.0f + __expf(-x)); }
__device__ __forceinline__ float sigm_f(float x) { return __builtin_amdgcn_rcpf(1.0f + __expf(-x)); }
__device__ __forceinline__ float bfl(unsigned w) { return __uint_as_float(w << 16); }
__device__ __forceinline__ float bfh(unsigned w) { return __uint_as_float(w & 0xffff0000u); }

struct EpiStoreBf16 {
    static constexpr bool PERM = true, AFTER_DRAIN = false; static constexpr int NST = 0;
    bf16_t* O; int ldc; int NT;
    __device__ __forceinline__ void operator()(const f32x4 (&acc)[2][2][4][2], const Unit& u, int wr, int wc, int fr, int fq) const {
        const int row0 = u.pm * BM + wr * 64 + fr, col0 = (u.pn % NT) * BM + wc * 32 + 8 * fq;
#pragma unroll
        for (int ai = 0; ai < 2; ++ai)
#pragma unroll
            for (int m = 0; m < 4; ++m) { bf16_t* rowp = O + (size_t)(row0 + ai * HALF + m * 16) * ldc + col0;
#pragma unroll
                for (int bj = 0; bj < 2; ++bj) { const f32x4 v0 = acc[ai][bj][m][0], v1 = acc[ai][bj][m][1];
                    u32x4 w; w.x = cvt_pk_bf16(v0[0], v0[1]); w.y = cvt_pk_bf16(v0[2], v0[3]); w.z = cvt_pk_bf16(v1[0], v1[1]); w.w = cvt_pk_bf16(v1[2], v1[3]);
                    *(u32x4*)(rowp + bj * HALF) = w; } }
    }
};
template <bool F8 = false>
struct EpiStoreBf16i8 {
    static constexpr bool PERM = true, AFTER_DRAIN = false; static constexpr int NST = 16;
    bf16_t* O; int ldc; const float* sA; const float* sB; int NT;
    __device__ __forceinline__ void operator()(const f32x4 (&acc)[2][2][4][2], const Unit& u, int wr, int wc, int fr, int fq) const {
        const int row0 = u.pm * BM + wr * 64 + fr, col0 = (u.pn % NT) * BM + wc * 32 + 8 * fq, bcol0 = u.pn * BM + wc * 32 + 8 * fq;
        f32x4 sb[2][2];
#pragma unroll
        for (int bj = 0; bj < 2; ++bj) { sb[bj][0] = *(const PG8_G f32x4*)(sB + bcol0 + bj * HALF); sb[bj][1] = *(const PG8_G f32x4*)(sB + bcol0 + bj * HALF + 4); }
        float sav[2][4];
#pragma unroll
        for (int ai = 0; ai < 2; ++ai)
#pragma unroll
            for (int m = 0; m < 4; ++m) sav[ai][m] = F8 ? 1.0f : ((const PG8_G float*)sA)[row0 + ai * HALF + m * 16];
#pragma unroll
        for (int ai = 0; ai < 2; ++ai)
#pragma unroll
            for (int m = 0; m < 4; ++m) { const int row = row0 + ai * HALF + m * 16; bf16_t* rowp = O + (size_t)row * ldc + col0; const float sa = sav[ai][m];
#pragma unroll
                for (int bj = 0; bj < 2; ++bj) { const i32x4 i0 = __builtin_bit_cast(i32x4, acc[ai][bj][m][0]), i1 = __builtin_bit_cast(i32x4, acc[ai][bj][m][1]); f32x4 v0, v1;
#pragma unroll
                    for (int j = 0; j < 4; ++j) { if constexpr (F8) { v0[j] = acc[ai][bj][m][0][j] * sb[bj][0][j]; v1[j] = acc[ai][bj][m][1][j] * sb[bj][1][j]; } else { v0[j] = (float)i0[j] * (sa * sb[bj][0][j]); v1[j] = (float)i1[j] * (sa * sb[bj][1][j]); } }
                    u32x4 w; w.x = cvt_pk_bf16(v0[0], v0[1]); w.y = cvt_pk_bf16(v0[2], v0[3]); w.z = cvt_pk_bf16(v1[0], v1[1]); w.w = cvt_pk_bf16(v1[2], v1[3]);
                    *(PG8_G u32x4*)(rowp + bj * HALF) = w; } }
    }
};
struct EpiSwiGLU {
    static constexpr bool PERM = true, AFTER_DRAIN = false; static constexpr int NST = 0;
    bf16_t* O; int ldc; int NT;
    __device__ __forceinline__ void operator()(const f32x4 (&acc)[2][2][4][2], const Unit& u, int wr, int wc, int fr, int fq) const {
        const int ct = u.pn % NT; const int row0 = u.pm * BM + wr * 64 + fr, col0 = ct * HALF + wc * 32 + 8 * fq;
#pragma unroll
        for (int ai = 0; ai < 2; ++ai)
#pragma unroll
            for (int m = 0; m < 4; ++m) { bf16_t* rowp = O + (size_t)(row0 + ai * HALF + m * 16) * ldc + col0;
                const f32x4 g0 = acc[ai][0][m][0], g1 = acc[ai][0][m][1], u0 = acc[ai][1][m][0], u1 = acc[ai][1][m][1];
                u32x4 w; w.x = cvt_pk_bf16(silu_f(g0[0]) * u0[0], silu_f(g0[1]) * u0[1]); w.y = cvt_pk_bf16(silu_f(g0[2]) * u0[2], silu_f(g0[3]) * u0[3]);
                w.z = cvt_pk_bf16(silu_f(g1[0]) * u1[0], silu_f(g1[1]) * u1[1]); w.w = cvt_pk_bf16(silu_f(g1[2]) * u1[2], silu_f(g1[3]) * u1[3]);
                *(PG8_G u32x4*)rowp = w; }
    }
};
struct EpiSwiGLUi8 {
    static constexpr bool PERM = true, AFTER_DRAIN = false; static constexpr int NST = 0;
    bf16_t* O; int ldc; int NT; const float* sA; const float* sB;
    __device__ __forceinline__ void operator()(const f32x4 (&acc)[2][2][4][2], const Unit& u, int wr, int wc, int fr, int fq) const {
        const int ct = u.pn % NT; const int row0 = u.pm * BM + wr * 64 + fr, col0 = ct * HALF + wc * 32 + 8 * fq; const float* sb = sB + (size_t)u.pn * BM + wc * 32 + 8 * fq;
        const f32x4 sg0 = *(const PG8_G f32x4*)sb, sg1 = *(const PG8_G f32x4*)(sb + 4), su0 = *(const PG8_G f32x4*)(sb + HALF), su1 = *(const PG8_G f32x4*)(sb + HALF + 4);
        float sav[2][4];
#pragma unroll
        for (int ai = 0; ai < 2; ++ai)
#pragma unroll
            for (int m = 0; m < 4; ++m) sav[ai][m] = ((const PG8_G float*)sA)[row0 + ai * HALF + m * 16];
#pragma unroll
        for (int ai = 0; ai < 2; ++ai)
#pragma unroll
            for (int m = 0; m < 4; ++m) { const int row = row0 + ai * HALF + m * 16; bf16_t* rowp = O + (size_t)row * ldc + col0; const float sa = sav[ai][m];
                const i32x4 gi0 = __builtin_bit_cast(i32x4, acc[ai][0][m][0]), gi1 = __builtin_bit_cast(i32x4, acc[ai][0][m][1]), ui0 = __builtin_bit_cast(i32x4, acc[ai][1][m][0]), ui1 = __builtin_bit_cast(i32x4, acc[ai][1][m][1]);
                f32x4 g0, g1, u0, u1;
#pragma unroll
                for (int j = 0; j < 4; ++j) { g0[j] = (float)gi0[j] * (sa * sg0[j]); g1[j] = (float)gi1[j] * (sa * sg1[j]); u0[j] = (float)ui0[j] * (sa * su0[j]); u1[j] = (float)ui1[j] * (sa * su1[j]); }
                u32x4 w; w.x = cvt_pk_bf16(silu_f(g0[0]) * u0[0], silu_f(g0[1]) * u0[1]); w.y = cvt_pk_bf16(silu_f(g0[2]) * u0[2], silu_f(g0[3]) * u0[3]);
                w.z = cvt_pk_bf16(silu_f(g1[0]) * u1[0], silu_f(g1[1]) * u1[1]); w.w = cvt_pk_bf16(silu_f(g1[2]) * u1[2], silu_f(g1[3]) * u1[3]);
                *(PG8_G u32x4*)rowp = w; }
    }
};
struct EpiSwiGLUf8 {
    static constexpr bool PERM = true, AFTER_DRAIN = false; static constexpr int NST = 4;
    unsigned char* O; int ldc; int NT; const float* sA; const float* sB;
    __device__ __forceinline__ void operator()(const f32x4 (&acc)[2][2][4][2], const Unit& u, int wr, int wc, int fr, int fq) const {
        const int ct = u.pn % NT; const int row0 = u.pm * BM + wr * 64 + fr, colw = ct * HALF + wc * 32 + 16 * (fq >> 1), odd = fq & 1; const float* sb = sB + (size_t)u.pn * BM + wc * 32 + 8 * fq;
        const f32x4 sg0 = *(const PG8_G f32x4*)sb, sg1 = *(const PG8_G f32x4*)(sb + 4), su0 = *(const PG8_G f32x4*)(sb + HALF), su1 = *(const PG8_G f32x4*)(sb + HALF + 4);
        float sav[2][4];
#pragma unroll
        for (int ai = 0; ai < 2; ++ai)
#pragma unroll
            for (int m = 0; m < 4; ++m) sav[ai][m] = ((const PG8_G float*)sA)[row0 + ai * HALF + m * 16];
#pragma unroll
        for (int ai = 0; ai < 2; ++ai)
#pragma unroll
            for (int mp = 0; mp < 2; ++mp) { unsigned pk[2][2];
#pragma unroll
                for (int mm = 0; mm < 2; ++mm) { const int m = mp * 2 + mm; const float sa = sav[ai][m];
                    const i32x4 gi0 = __builtin_bit_cast(i32x4, acc[ai][0][m][0]), gi1 = __builtin_bit_cast(i32x4, acc[ai][0][m][1]), ui0 = __builtin_bit_cast(i32x4, acc[ai][1][m][0]), ui1 = __builtin_bit_cast(i32x4, acc[ai][1][m][1]);
                    float o[8];
#pragma unroll
                    for (int j = 0; j < 4; ++j) { const float g0 = (float)gi0[j] * (sa * sg0[j]), g1 = (float)gi1[j] * (sa * sg1[j]), u0 = (float)ui0[j] * (sa * su0[j]), u1 = (float)ui1[j] * (sa * su1[j]);
                        o[j] = __builtin_amdgcn_fmed3f(silu_f(g0) * u0, -448.0f, 448.0f); o[4 + j] = __builtin_amdgcn_fmed3f(silu_f(g1) * u1, -448.0f, 448.0f); }
                    int lo = __builtin_amdgcn_cvt_pk_fp8_f32(o[0], o[1], 0, false); lo = __builtin_amdgcn_cvt_pk_fp8_f32(o[2], o[3], lo, true);
                    int hi = __builtin_amdgcn_cvt_pk_fp8_f32(o[4], o[5], 0, false); hi = __builtin_amdgcn_cvt_pk_fp8_f32(o[6], o[7], hi, true);
                    pk[mm][0] = (unsigned)lo; pk[mm][1] = (unsigned)hi; }
                const u32x2 r0 = __builtin_amdgcn_permlane16_swap(pk[0][0], pk[1][0], false, false), r1 = __builtin_amdgcn_permlane16_swap(pk[0][1], pk[1][1], false, false);
                u32x4 w; w.x = r0[0]; w.y = r1[0]; w.z = r0[1]; w.w = r1[1];
                *(PG8_G u32x4*)(O + (size_t)(row0 + ai * HALF + (mp * 2 + odd) * 16) * ldc + colw) = w; }
    }
};
struct EpiResid {
    static constexpr bool PERM = false, AFTER_DRAIN = false; static constexpr int NST = 0;
    float* X; const float* gate;
    __device__ __forceinline__ void operator()(const f32x4 (&acc)[2][2][4][2], const Unit& u, int wr, int wc, int fr, int fq) const {
        const int v = u.pm < 4 ? 4 : ((u.pm - 4) >> 5);
        const int row0 = u.pm * BM + wr * 64 + fr, col0 = u.pn * BM + wc * 32 + 4 * fq;
        const float* gv = gate + (size_t)v * 6144 + col0;
        f32x4 gg[2][2];
#pragma unroll
        for (int bj = 0; bj < 2; ++bj)
#pragma unroll
            for (int n = 0; n < 2; ++n) gg[bj][n] = *(const PG8_G f32x4*)(gv + bj * HALF + n * 16);
#pragma unroll
        for (int ai = 0; ai < 2; ++ai) {
            f32x4 xv[4][2][2];
#pragma unroll
            for (int m = 0; m < 4; ++m) { const float* rowp = X + (size_t)(row0 + ai * HALF + m * 16) * 1024 + col0;
#pragma unroll
                for (int bj = 0; bj < 2; ++bj)
#pragma unroll
                    for (int n = 0; n < 2; ++n) xv[m][bj][n] = *(const PG8_G f32x4*)(rowp + bj * HALF + n * 16); }
#pragma unroll
            for (int m = 0; m < 4; ++m) { float* rowp = X + (size_t)(row0 + ai * HALF + m * 16) * 1024 + col0;
#pragma unroll
                for (int bj = 0; bj < 2; ++bj)
#pragma unroll
                    for (int n = 0; n < 2; ++n) *(f32x4*)(rowp + bj * HALF + n * 16) = xv[m][bj][n] + gg[bj][n] * acc[ai][bj][m][n]; }
        }
    }
};
template <bool F8 = false>
struct EpiResidI8 {
    static constexpr bool PERM = true, AFTER_DRAIN = false; static constexpr int NST = 16;
    bf16_t* X; const float* gate; const float* sA; const float* sB; const float* rdc; const float* rdl; int rdf;
    __device__ __forceinline__ void operator()(const f32x4 (&acc)[2][2][4][2], const Unit& u, int wr, int wc, int fr, int fq) const {
        const int v = u.pm < 4 ? 4 : ((u.pm - 4) >> 5);
        const int row0 = u.pm * BM + wr * 64 + fr, col0 = u.pn * BM + wc * 32 + 8 * fq;
        const float* gv = gate + (size_t)v * 6144 + col0;
        f32x4 gg[2][2]; float sav[2][4];
#pragma unroll
        for (int bj = 0; bj < 2; ++bj)
#pragma unroll
            for (int n = 0; n < 2; ++n) gg[bj][n] = *(const PG8_G f32x4*)(gv + bj * HALF + n * 4) * *(const PG8_G f32x4*)(sB + col0 + bj * HALF + n * 4);
#pragma unroll
        for (int ai = 0; ai < 2; ++ai)
#pragma unroll
            for (int m = 0; m < 4; ++m) sav[ai][m] = F8 ? 1.0f : ((const PG8_G float*)sA)[row0 + ai * HALF + m * 16];
        if (rdf) {
            const float* rb = u.pm < 4 ? rdc : rdl;
#pragma unroll
            for (int ai = 0; ai < 2; ++ai)
#pragma unroll
                for (int mh = 0; mh < 2; ++mh) {
                    f32x4 xv[2][2][2];
#pragma unroll
                    for (int mm = 0; mm < 2; ++mm) { const float* rowp = rb + (size_t)(row0 + ai * HALF + (mh * 2 + mm) * 16) * 1024 + col0;
#pragma unroll
                        for (int bj = 0; bj < 2; ++bj)
#pragma unroll
                            for (int n = 0; n < 2; ++n) xv[mm][bj][n] = *(const PG8_G f32x4*)(rowp + bj * HALF + n * 4); }
#pragma unroll
                    for (int mm = 0; mm < 2; ++mm) { const int m = mh * 2 + mm; bf16_t* rowp = X + (size_t)(row0 + ai * HALF + m * 16) * 1024 + col0;
#pragma unroll
                        for (int bj = 0; bj < 2; ++bj) { f32x4 o[2];
#pragma unroll
                            for (int n = 0; n < 2; ++n) { const i32x4 iv = __builtin_bit_cast(i32x4, acc[ai][bj][m][n]); f32x4 fv; if constexpr (F8) fv = acc[ai][bj][m][n]; else { fv[0] = (float)iv[0]; fv[1] = (float)iv[1]; fv[2] = (float)iv[2]; fv[3] = (float)iv[3]; }
                                o[n] = xv[mm][bj][n] + gg[bj][n] * (fv * sav[ai][m]); }
                            u32x4 wv; wv.x = cvt_pk_bf16(o[0][0], o[0][1]); wv.y = cvt_pk_bf16(o[0][2], o[0][3]); wv.z = cvt_pk_bf16(o[1][0], o[1][1]); wv.w = cvt_pk_bf16(o[1][2], o[1][3]);
                            *(PG8_G u32x4*)(rowp + bj * HALF) = wv; } }
                    asm volatile("" ::: "memory");
                }
        } else {
#pragma unroll
            for (int ai = 0; ai < 2; ++ai)
#pragma unroll
                for (int mh = 0; mh < 2; ++mh) {
                    u32x4 xw[2][2];
#pragma unroll
                    for (int mm = 0; mm < 2; ++mm) { const bf16_t* rowp = X + (size_t)(row0 + ai * HALF + (mh * 2 + mm) * 16) * 1024 + col0;
#pragma unroll
                        for (int bj = 0; bj < 2; ++bj) xw[mm][bj] = *(const PG8_G u32x4*)(rowp + bj * HALF); }
#pragma unroll
                    for (int mm = 0; mm < 2; ++mm) { const int m = mh * 2 + mm; bf16_t* rowp = X + (size_t)(row0 + ai * HALF + m * 16) * 1024 + col0;
#pragma unroll
                        for (int bj = 0; bj < 2; ++bj) { const u32x4 q = xw[mm][bj]; f32x4 o[2];
                            o[0][0] = bfl(q.x); o[0][1] = bfh(q.x); o[0][2] = bfl(q.y); o[0][3] = bfh(q.y); o[1][0] = bfl(q.z); o[1][1] = bfh(q.z); o[1][2] = bfl(q.w); o[1][3] = bfh(q.w);
#pragma unroll
                            for (int n = 0; n < 2; ++n) { const i32x4 iv = __builtin_bit_cast(i32x4, acc[ai][bj][m][n]); f32x4 fv; if constexpr (F8) fv = acc[ai][bj][m][n]; else { fv[0] = (float)iv[0]; fv[1] = (float)iv[1]; fv[2] = (float)iv[2]; fv[3] = (float)iv[3]; }
                                o[n] = o[n] + gg[bj][n] * (fv * sav[ai][m]); }
                            u32x4 wv; wv.x = cvt_pk_bf16(o[0][0], o[0][1]); wv.y = cvt_pk_bf16(o[0][2], o[0][3]); wv.z = cvt_pk_bf16(o[1][0], o[1][1]); wv.w = cvt_pk_bf16(o[1][2], o[1][3]);
                            *(PG8_G u32x4*)(rowp + bj * HALF) = wv; } }
                    asm volatile("" ::: "memory");
                }
        }
    }
};
struct EpiGate {
    static constexpr bool PERM = true, AFTER_DRAIN = false; static constexpr int NST = 16;
    const bf16_t* P; bf16_t* YG; const float* SSQ;
    __device__ __forceinline__ void operator()(const f32x4 (&acc)[2][2][4][2], const Unit& u, int wr, int wc, int fr, int fq) const {
        const int br = u.pn >> 2, rt = u.pm - br * 132;
        const int row0 = rt * BM + wr * 64 + fr, col0 = u.pn * BM + wc * 32 + 8 * fq;
        float rsn[2][4];
#pragma unroll
        for (int ai = 0; ai < 2; ++ai)
#pragma unroll
            for (int m = 0; m < 4; ++m) rsn[ai][m] = 1.0f;
        if (br == 0) {
            f32x4 q[2][4][2];
#pragma unroll
            for (int ai = 0; ai < 2; ++ai)
#pragma unroll
                for (int m = 0; m < 4; ++m) { const float* sp = SSQ + (size_t)(row0 + ai * HALF + m * 16) * 8; q[ai][m][0] = *(const PG8_G f32x4*)sp; q[ai][m][1] = *(const PG8_G f32x4*)(sp + 4); }
#pragma unroll
            for (int ai = 0; ai < 2; ++ai)
#pragma unroll
                for (int m = 0; m < 4; ++m) { const f32x4 q0 = q[ai][m][0], q1 = q[ai][m][1]; rsn[ai][m] = __builtin_amdgcn_rsqf(((q0[0] + q0[1]) + (q0[2] + q0[3]) + (q1[0] + q1[1]) + (q1[2] + q1[3])) * (1.0f / 512.0f) + 1e-6f); }
        }
#pragma unroll
        for (int ai = 0; ai < 2; ++ai) {
            u32x4 gw[4][2];
#pragma unroll
            for (int m = 0; m < 4; ++m)
#pragma unroll
                for (int bj = 0; bj < 2; ++bj) gw[m][bj] = *(const PG8_G u32x4*)(P + (size_t)(row0 + ai * HALF + m * 16) * P_STRIDE + 3840 + col0 + bj * HALF);
#pragma unroll
            for (int m = 0; m < 4; ++m)
#pragma unroll
                for (int bj = 0; bj < 2; ++bj) { const u32x4 g = gw[m][bj]; const f32x4 v0 = acc[ai][bj][m][0] * rsn[ai][m], v1 = acc[ai][bj][m][1] * rsn[ai][m];
                    u32x4 w; w.x = cvt_pk_bf16(v0[0] * sigm_f(bfl(g.x)), v0[1] * sigm_f(bfh(g.x))); w.y = cvt_pk_bf16(v0[2] * sigm_f(bfl(g.y)), v0[3] * sigm_f(bfh(g.y)));
                    w.z = cvt_pk_bf16(v1[0] * sigm_f(bfl(g.z)), v1[1] * sigm_f(bfh(g.z))); w.w = cvt_pk_bf16(v1[2] * sigm_f(bfl(g.w)), v1[3] * sigm_f(bfh(g.w)));
                    *(PG8_G u32x4*)(YG + (size_t)(row0 + ai * HALF + m * 16) * 3072 + col0 + bj * HALF) = w; }
        }
    }
};
struct EpiStoreF32 {
    static constexpr bool PERM = false, AFTER_DRAIN = false; static constexpr int NST = 0;
    float* Y; int NT;
    __device__ __forceinline__ void operator()(const f32x4 (&acc)[2][2][4][2], const Unit& u, int wr, int wc, int fr, int fq) const {
        const int ct = u.pn % NT; const int row0 = u.pm * BM + wr * 64 + fr, col0 = ct * BM + wc * 32 + 4 * fq;
#pragma unroll
        for (int ai = 0; ai < 2; ++ai)
#pragma unroll
            for (int m = 0; m < 4; ++m) { float* rowp = Y + (size_t)(row0 + ai * HALF + m * 16) * 1024 + col0;
#pragma unroll
                for (int bj = 0; bj < 2; ++bj)
#pragma unroll
                    for (int n = 0; n < 2; ++n) *(f32x4*)(rowp + bj * HALF + n * 16) = acc[ai][bj][m][n]; }
    }
};
struct MergeOrder : StaticOrder {
    __device__ __forceinline__ bool next(int i, Unit& u) const { if (!StaticOrder::next(i, u)) return false; u.pm += (u.pn >> 2) * 132; return true; }
};
struct MoeOrder {
    int R, NT, G, c; int ts[9];
    __device__ __forceinline__ bool next(int i, Unit& u) const {
        const int nwg = R * NT; const long L = (long)i * G + c; if (L >= nwg) return false;
        int wgid = (int)L; { const int q = nwg / NXCD, r = nwg % NXCD, xcd = wgid % NXCD, off = wgid / NXCD; wgid = (xcd < r ? xcd * (q + 1) : r * (q + 1) + (xcd - r) * q) + off; }
        const int nig = WGM * NT, gid = wgid / nig, fm = gid * WGM, gsz = (R - fm) < WGM ? (R - fm) : WGM;
        const int pm = fm + ((wgid % nig) % gsz), ct = (wgid % nig) / gsz;
        int e = 0;
#pragma unroll
        for (int j = 1; j < 8; ++j) e += (pm >= ts[j]) ? 1 : 0;
        u.pm = pm; u.pn = e * NT + ct; return true;
    }
    __device__ __forceinline__ void a_ready(const Unit&) const {}
    __device__ __forceinline__ void done(const Unit&) const {}
};
template <bool I8> __device__ __forceinline__ f32x4 mma16(bf16x8 b, bf16x8 a, f32x4 c) {
    if constexpr (I8) return __builtin_bit_cast(f32x4, __builtin_amdgcn_mfma_i32_16x16x64_i8(__builtin_bit_cast(i32x4, b), __builtin_bit_cast(i32x4, a), __builtin_bit_cast(i32x4, c), 0, 0, 0));
    else return __builtin_amdgcn_mfma_f32_16x16x32_bf16(b, a, c, 0, 0, 0);
}
__device__ __forceinline__ f32x4 mma_f8(bf16x8 b0, bf16x8 b1, bf16x8 a0, bf16x8 a1, f32x4 c) {
    const i32x8 bb = __builtin_shufflevector(__builtin_bit_cast(i32x4, b0), __builtin_bit_cast(i32x4, b1), 0, 1, 2, 3, 4, 5, 6, 7), aa = __builtin_shufflevector(__builtin_bit_cast(i32x4, a0), __builtin_bit_cast(i32x4, a1), 0, 1, 2, 3, 4, 5, 6, 7);
    asm volatile("s_nop 1\n\tv_mfma_f32_16x16x128_f8f6f4 %0, %1, %2, %0" : "+v"(c) : "v"(bb), "v"(aa));
    return c;
}
template <class Epi, class Sched, bool ALIGN_EPI = false, bool SP2 = false, bool I8 = false, bool F8 = false>
__device__ __forceinline__ void gemm_phase(PG8_LAS unsigned char* lds, const Gemm g, const Sched& S, const Epi& E) {
    int tid_ = threadIdx.x; asm volatile("" : "+v"(tid_));
    const int tid = tid_, wid = __builtin_amdgcn_readfirstlane(tid >> 6), lane = tid & 63, wr = wid >> 2, wc = wid & 3, fr = lane & 15, fq = lane >> 4;
    const int K = g.K, nt = K / BK;
    unsigned voffA, voffB;
    { int R, C; stage_rc(tid * 16, R, C); const int Rb = Epi::PERM ? ((R & ~31) + perm32(R & 31)) : R; voffA = (unsigned)(R * K + C) * 2u; voffB = (unsigned)(Rb * K + C) * 2u; }
    const size_t pstep = (size_t)64 * K * 2;
    const size_t kstep = (size_t)(BK * 2);
    const size_t hstep = (size_t)HALF * K * 2;
    const size_t tstep = 2 * hstep;
    const unsigned ldsw = (unsigned)wid * 1024u;
    const int aoff = lds_byte(wr * 64 + fr, fq * 8), boff = lds_byte(wc * 32 + fr, fq * 8);
#define PG8_SA(b, h) (((b) * 2 + (h)) * HTB)
#define PG8_SB(b, h) ((4 + (b) * 2 + (h)) * HTB)
#define PG8_STAGE(bufoff, gbase, voff) do { _Pragma("unroll") for (int _i = 0; _i < 2; ++_i) \
        __builtin_amdgcn_global_load_lds((const unsigned*)((const char*)(gbase) + _i * pstep + (voff)), (PG8_LAS unsigned*)(lds + (bufoff) + ldsw + _i * 8192), 16, 0, 0); } while (0)
#define PG8_LDA(dst, b, h) do { _Pragma("unroll") for (int m = 0; m < 4; ++m) _Pragma("unroll") for (int k = 0; k < 2; ++k) dst[m][k] = *(const PG8_LAS bf16x8*)(lds + PG8_SA(b, h) + aoff + m * 2048 + k * 1024); } while (0)
#define PG8_LDB(dst, b, h) do { _Pragma("unroll") for (int n = 0; n < 2; ++n) _Pragma("unroll") for (int k = 0; k < 2; ++k) dst[n][k] = *(const PG8_LAS bf16x8*)(lds + PG8_SB(b, h) + boff + n * 2048 + k * 1024); } while (0)
#define PG8_MMA(ai, bj, At, Bt) do { __builtin_amdgcn_s_setprio(1); _Pragma("unroll") for (int m = 0; m < 4; ++m) _Pragma("unroll") for (int n = 0; n < 2; ++n) { \
        if constexpr (F8) acc[ai][bj][m][n] = mma_f8(Bt[n][0], Bt[n][1], At[m][0], At[m][1], acc[ai][bj][m][n]); \
        else { _Pragma("unroll") for (int k = 0; k < 2; ++k) acc[ai][bj][m][n] = mma16<I8>(Bt[n][k], At[m][k], acc[ai][bj][m][n]); } } __builtin_amdgcn_s_setprio(0); } while (0)
#define PG8_WAIT_V(n) asm volatile("s_waitcnt vmcnt(" #n ")" ::: "memory")
#define PG8_WAIT_VF asm volatile("s_waitcnt vmcnt(%0)" :: "n"(8 + Epi::NST) : "memory")
#define PG8_WAIT_L(n) asm volatile("s_waitcnt lgkmcnt(" #n ")" ::: "memory")
#define PG8_BAR __builtin_amdgcn_s_barrier()
#define PG8_SCHED __builtin_amdgcn_sched_barrier(0)
    Unit cur, nxt; int ui = 0;
    if (!S.next(0, cur)) return;
    f32x4 acc[2][2][4][2];
#pragma unroll
    for (int a = 0; a < 2; ++a)
#pragma unroll
        for (int b = 0; b < 2; ++b)
#pragma unroll
            for (int m = 0; m < 4; ++m)
#pragma unroll
                for (int n = 0; n < 2; ++n) acc[a][b][m][n] = (f32x4){0.f, 0.f, 0.f, 0.f};
    bf16x8 At[4][2], B0[2][2], B1[2][2];
    const char* cA = (const char*)g.A + (size_t)cur.pm * tstep; const char* cB = (const char*)g.Bt + (size_t)cur.pn * tstep;
    S.a_ready(cur);
    if constexpr (SP2) {
        PG8_STAGE(PG8_SB(0, 0), cB, voffB); PG8_STAGE(PG8_SB(0, 1), cB + hstep, voffB); PG8_STAGE(PG8_SA(0, 0), cA, voffA); PG8_STAGE(PG8_SA(0, 1), cA + hstep, voffA);
        if (wr == 1) PG8_BAR;
        PG8_WAIT_V(2); PG8_BAR;
        PG8_STAGE(PG8_SB(1, 0), cB + kstep, voffB); PG8_STAGE(PG8_SA(1, 0), cA + kstep, voffA); PG8_STAGE(PG8_SB(1, 1), cB + hstep + kstep, voffB);
        if constexpr (Epi::NST > 0) { PG8_WAIT_V(0); } else { PG8_WAIT_V(6); } PG8_BAR;
    } else {
        PG8_STAGE(PG8_SB(0, 0), cB, voffB); PG8_STAGE(PG8_SA(0, 0), cA, voffA); PG8_STAGE(PG8_SB(0, 1), cB + hstep, voffB); PG8_STAGE(PG8_SA(0, 1), cA + hstep, voffA);
        if (wr == 1) PG8_BAR;
        PG8_WAIT_V(4); PG8_BAR;
        PG8_STAGE(PG8_SB(1, 0), cB + kstep, voffB); PG8_STAGE(PG8_SA(1, 0), cA + kstep, voffA); PG8_STAGE(PG8_SB(1, 1), cB + hstep + kstep, voffB);
        PG8_WAIT_V(6); PG8_BAR;
    }
    for (;;) {
        const bool has_next = S.next(ui + 1, nxt);
        const char* nA = has_next ? (const char*)g.A + (size_t)nxt.pm * tstep : cA; const char* nB = has_next ? (const char*)g.Bt + (size_t)nxt.pn * tstep : cB;
#define PG8_KT2(WV) \
              \
              \
            PG8_LDB(B0, 0, 0); PG8_LDB(B1, 0, 1); PG8_SCHED; PG8_LDA(At, 0, 0); PG8_STAGE(PG8_SA(1, 1), a1 + hstep, voffA); \
            WV; PG8_WAIT_L(0); PG8_BAR; PG8_MMA(0, 0, At, B0); PG8_MMA(0, 1, At, B1); PG8_BAR; PG8_SCHED; \
              \
            PG8_LDA(At, 0, 1); PG8_STAGE(PG8_SB(0, 0), b2, voffB); PG8_STAGE(PG8_SB(0, 1), b2 + hstep, voffB); PG8_STAGE(PG8_SA(0, 0), a2, voffA); \
            WV; PG8_WAIT_L(0); PG8_BAR; PG8_MMA(1, 0, At, B0); PG8_MMA(1, 1, At, B1); PG8_BAR; PG8_SCHED; \
              \
            PG8_LDB(B0, 1, 0); PG8_LDB(B1, 1, 1); PG8_SCHED; PG8_LDA(At, 1, 0); PG8_STAGE(PG8_SA(0, 1), a2 + hstep, voffA); \
            PG8_WAIT_V(8); PG8_WAIT_L(0); PG8_BAR; PG8_MMA(0, 0, At, B0); PG8_MMA(0, 1, At, B1); PG8_BAR; PG8_SCHED; \
              \
            PG8_LDA(At, 1, 1); PG8_STAGE(PG8_SB(1, 0), b3, voffB); PG8_STAGE(PG8_SB(1, 1), b3 + hstep, voffB); PG8_STAGE(PG8_SA(1, 0), a3, voffA); \
            PG8_WAIT_V(8); PG8_WAIT_L(0); PG8_BAR; PG8_MMA(1, 0, At, B0); PG8_MMA(1, 1, At, B1); PG8_BAR; PG8_SCHED;
        if constexpr (SP2) {
            if constexpr (Epi::NST > 0) {
                const char* a1 = cA + kstep; const char* a2 = cA + 2 * kstep; const char* b2 = cB + 2 * kstep; const char* a3 = a2 + kstep; const char* b3 = b2 + kstep;
                PG8_KT2(PG8_WAIT_VF)
            }
            for (int t = Epi::NST > 0 ? 2 : 0; t < nt; t += 2) {
                const bool last = (t == nt - 2);
                const char* a1 = cA + (size_t)(t + 1) * kstep;
                const char* a2 = last ? nA : cA + (size_t)(t + 2) * kstep; const char* b2 = last ? nB : cB + (size_t)(t + 2) * kstep;
                const char* a3 = a2 + kstep; const char* b3 = b2 + kstep;
                if (last && has_next) S.a_ready(nxt);
                PG8_KT2(PG8_WAIT_V(8))
            }
        } else {
        static_assert(SP2 || Epi::NST == 0, "the four-phase loop keeps the plain waits");
        for (int t = 0; t < nt; t += 2) {
            const bool last = (t == nt - 2);
            const char* a1 = cA + (size_t)(t + 1) * kstep;
            const char* a2 = last ? nA : cA + (size_t)(t + 2) * kstep; const char* b2 = last ? nB : cB + (size_t)(t + 2) * kstep;
            const char* a3 = a2 + kstep; const char* b3 = b2 + kstep;
            if (last && has_next) S.a_ready(nxt);
            PG8_LDB(B0, 0, 0); PG8_SCHED; PG8_LDA(At, 0, 0); PG8_STAGE(PG8_SA(1, 1), a1 + hstep, voffA);
            PG8_WAIT_L(8); PG8_BAR; PG8_WAIT_L(0); PG8_MMA(0, 0, At, B0); PG8_BAR; PG8_SCHED;
            PG8_LDB(B1, 0, 1); PG8_STAGE(PG8_SB(0, 0), b2, voffB);
            PG8_BAR; PG8_WAIT_L(0); PG8_MMA(0, 1, At, B1); PG8_BAR;
            PG8_LDA(At, 0, 1); PG8_STAGE(PG8_SA(0, 0), a2, voffA);
            PG8_BAR; PG8_WAIT_L(0); PG8_MMA(1, 0, At, B0); PG8_BAR; PG8_SCHED;
            PG8_STAGE(PG8_SB(0, 1), b2 + hstep, voffB);
            PG8_WAIT_V(6); PG8_BAR; PG8_MMA(1, 1, At, B1); PG8_BAR;
            PG8_LDB(B0, 1, 0); PG8_SCHED; PG8_LDA(At, 1, 0); PG8_STAGE(PG8_SA(0, 1), a2 + hstep, voffA);
            PG8_WAIT_L(8); PG8_BAR; PG8_WAIT_L(0); PG8_MMA(0, 0, At, B0); PG8_BAR; PG8_SCHED;
            PG8_LDB(B1, 1, 1); PG8_STAGE(PG8_SB(1, 0), b3, voffB);
            PG8_BAR; PG8_WAIT_L(0); PG8_MMA(0, 1, At, B1); PG8_BAR;
            PG8_LDA(At, 1, 1); PG8_STAGE(PG8_SA(1, 0), a3, voffA);
            PG8_BAR; PG8_WAIT_L(0); PG8_MMA(1, 0, At, B0); PG8_BAR; PG8_SCHED;
            PG8_STAGE(PG8_SB(1, 1), b3 + hstep, voffB);
            PG8_WAIT_V(6); PG8_BAR; PG8_MMA(1, 1, At, B1); PG8_BAR;
        }
        }
#undef PG8_KT2
        if constexpr (F8) asm volatile("s_nop 15\n\ts_nop 15" ::: "memory");
        if constexpr (ALIGN_EPI) { if (wr == 0) PG8_BAR; }
        if constexpr (!Epi::AFTER_DRAIN) { int te = tid; asm volatile("" : "+v"(te));
            E(acc, cur, wr, wc, te & 15, (te & 63) >> 4); S.done(cur); }
        if (!has_next) break;
#pragma unroll
        for (int a = 0; a < 2; ++a)
#pragma unroll
            for (int b = 0; b < 2; ++b)
#pragma unroll
                for (int m = 0; m < 4; ++m)
#pragma unroll
                    for (int n = 0; n < 2; ++n) acc[a][b][m][n] = (f32x4){0.f, 0.f, 0.f, 0.f};
        cur = nxt; cA = nA; cB = nB; ++ui;
        if constexpr (ALIGN_EPI) { if (wr == 1) PG8_BAR; }
    }
    PG8_WAIT_V(0);
    if constexpr (!ALIGN_EPI) { if (wr == 0) PG8_BAR; }
    PG8_BAR;
    if constexpr (Epi::AFTER_DRAIN) { E.fused(acc, cur, wr, wc, fr, fq, lds, wid, lane); S.done(cur); }
#undef PG8_SA
#undef PG8_SB
#undef PG8_STAGE
#undef PG8_LDA
#undef PG8_LDB
#undef PG8_MMA
#undef PG8_WAIT_V
#undef PG8_WAIT_L
#undef PG8_BAR
#undef PG8_SCHED
}
}

constexpr int D = 1024, NB = 4, SEQ = 8192, DEPTH = 4, CTXL = 256;
constexpr int NCTX = NB * CTXL;
constexpr int T = NCTX + NB * SEQ;
constexpr int NP = 6912;
constexpr int PS = pg8::P_STRIDE;
constexpr int FF = 2816, EFF = 3584, NEXP = 8;
constexpr int CAP = 2 * T + NEXP * 256;
constexpr int PC_Z = 0, PC_XBC = 512, PC_POOL = 1280, PC_Q = 1792, PC_K = 2304, PC_V = 2816, PC_G = 3328, PC_GATE = 3840, PC_DT = 6912;
constexpr float EPS = 1e-6f;

constexpr size_t MiB = 1u << 20;
constexpr size_t WS_CTL = 0, CTL_ZERO_BYTES = 1 * MiB;
constexpr size_t WS_MOD = 1 * MiB;
constexpr size_t WS_ROUTE = 2 * MiB;
constexpr size_t WS_SLOT = WS_ROUTE + (size_t)T * 16;
constexpr size_t WS_CNTT = WS_SLOT + (size_t)T * 8;
constexpr size_t WS_MOEINFO = WS_CNTT + 132 * 8 * 4;
constexpr size_t WS_ROPE = WS_MOEINFO + 64;
constexpr size_t WS_SA = WS_ROPE + 192 * 16 * 8;
constexpr size_t WS_SAS = WS_SA + (size_t)T * 4;
constexpr size_t WS_SB13 = WS_SAS + (size_t)CAP * 4;
constexpr size_t WS_SBM = WS_SB13 + (size_t)2 * 2 * FF * 4;
constexpr size_t WS_SBW = WS_SBM + (size_t)2 * NEXP * 2 * EFF * 4;
constexpr size_t WS_SBO = WS_SBW + (size_t)DEPTH * NP * 4;
constexpr size_t WS_SB2 = WS_SBO + (size_t)DEPTH * D * 4;
constexpr size_t WS_SBM2 = WS_SB2 + (size_t)2 * D * 4;
constexpr size_t WS_SA2 = WS_SBM2 + (size_t)2 * NEXP * D * 4;
constexpr size_t WS_SACT = WS_SA2 + (size_t)T * 4;
constexpr size_t WS_WDT8 = (WS_SACT + (size_t)CAP * 4 + 255) / 256 * 256;
constexpr size_t WS_SBDT = WS_WDT8 + (size_t)DEPTH * 16 * 1024;
constexpr size_t WS_X = 5 * MiB;
constexpr size_t WS_ABF = WS_X + (size_t)T * D * 4;
constexpr size_t WS_WIN = WS_ABF + (size_t)T * D * 2;
constexpr size_t WS_WBR = WS_WIN + (size_t)DEPTH * NP * D * 2;
constexpr size_t WS_WOUT = WS_WBR + (size_t)DEPTH * 3 * D * 512 * 2;
constexpr size_t WS_W13 = WS_WOUT + (size_t)DEPTH * D * D * 2;
constexpr size_t WS_W2 = WS_W13 + (size_t)2 * 2 * FF * D * 2;
constexpr size_t WS_M13 = WS_W2 + (size_t)2 * D * FF * 2;
constexpr size_t WS_M2 = WS_M13 + (size_t)2 * NEXP * 2 * EFF * D * 2;
constexpr size_t WS_R = WS_M2 + (size_t)2 * NEXP * D * EFF * 2;
constexpr size_t WS_P = WS_R;
constexpr size_t WS_XBC = WS_P + (size_t)T * PS * 2;
constexpr size_t WS_DT = WS_XBC + (size_t)T * 768 * 2;
constexpr size_t WS_QR = WS_DT + (size_t)T * 16 * 4;
constexpr size_t WS_KR = WS_QR + (size_t)T * 512 * 2;
constexpr int NCH = 66, NCID = NB * NCH;
constexpr size_t WS_ST = WS_KR + (size_t)T * 512 * 2;
constexpr size_t WS_YG = WS_ST;
constexpr size_t WS_PREV = WS_ST + (size_t)4 * NCID * 8 * 4096 * 4;
constexpr size_t WS_DEC = WS_PREV + (size_t)4 * NCID * 8 * 4096 * 2;
constexpr size_t WS_SSQ = WS_DEC + (size_t)4 * NCID * 8 * 4;
constexpr size_t WS_FR = WS_SSQ + (size_t)T * 8 * 4;
constexpr size_t WS_DTT = WS_FR + (size_t)NCID * 46 * 8192 * 2;
constexpr size_t WS_ABR = WS_DTT + (size_t)NCID * 16 * 128 * 4;
constexpr size_t WS_MIX_END = WS_ABR + (size_t)3 * T * 512 * 2;
constexpr size_t WS_ACT = WS_R;
constexpr size_t WS_SORT = WS_R;
constexpr size_t WS_ACTM = WS_SORT + (size_t)CAP * D * 2;
constexpr size_t WS_YB = WS_ACTM + (size_t)CAP * EFF * 2;
constexpr size_t WS_ACT8 = WS_YB + (size_t)CAP * D * 2;
constexpr size_t WS_FFN_END = WS_ACT8 + (size_t)CAP * EFF;
constexpr size_t WS_END = WS_MIX_END > WS_FFN_END ? WS_MIX_END : WS_FFN_END;
static_assert(WS_SBDT + 256 <= WS_X, "small tables");
static_assert(WS_END <= (size_t)1792 * MiB, "workspace");
static_assert((size_t)T * 3072 * 2 <= (size_t)4 * NCID * 8 * 4096 * 6, "YG fits over ST + PREV");
constexpr int CW_BAR = 4096;

constexpr int RING_BYTES = 131072, LDS_BYTES = 147456, MISC_OFF = LDS_BYTES - 256, NWAVES = 8;

#define LAS __attribute__((address_space(3)))
#define DEVI __device__ __forceinline__
typedef unsigned short bf16;
typedef unsigned v4u __attribute__((ext_vector_type(4)));
typedef unsigned v2u __attribute__((ext_vector_type(2)));
typedef int v4i __attribute__((ext_vector_type(4)));
typedef int v2i __attribute__((ext_vector_type(2)));
typedef float f32x4 __attribute__((ext_vector_type(4)));
#define LDS_WAIT() asm volatile("s_waitcnt lgkmcnt(0)" ::: "memory")
#define VM_WAIT() asm volatile("s_waitcnt vmcnt(0)" ::: "memory")
DEVI unsigned f2bf(float f) { unsigned u = __builtin_bit_cast(unsigned, f); return (u + 0x7fffu + ((u >> 16) & 1u)) >> 16; }
typedef __bf16 bf16n2 __attribute__((ext_vector_type(2)));
typedef float f32n2 __attribute__((ext_vector_type(2)));
DEVI unsigned pk2(float lo, float hi) { const f32n2 v = {lo, hi}; return __builtin_bit_cast(unsigned, __builtin_convertvector(v, bf16n2)); }
DEVI float bfl(unsigned w) { return __uint_as_float(w << 16); }
DEVI float bfh(unsigned w) { return __uint_as_float(w & 0xffff0000u); }
DEVI float silu_f(float x) { return x * __builtin_amdgcn_rcpf(1.0f + __expf(-x)); }
DEVI float wave_sum(float v) {
#pragma unroll
    for (int o = 1; o < 64; o <<= 1) v += __shfl_xor(v, o);
    return v;
}
DEVI void unpack8(const v4u w, float (&f)[8]) { f[0] = bfl(w.x); f[1] = bfh(w.x); f[2] = bfl(w.y); f[3] = bfh(w.y); f[4] = bfl(w.z); f[5] = bfh(w.z); f[6] = bfl(w.w); f[7] = bfh(w.w); }
DEVI v4u pack8(const float (&f)[8]) { v4u w; w.x = pk2(f[0], f[1]); w.y = pk2(f[2], f[3]); w.z = pk2(f[4], f[5]); w.w = pk2(f[6], f[7]); return w; }

#define XB_TMO      128
#define XB_XCNT(j)  (256  + 64 * (j))
#define XB_XSUB(j)  (1280 + 64 * (j))
#define XB_XGEN(j)  (2304 + 64 * (j))
#define XB_TOP      3328
#define XB_TOPGEN   3392
#define XCD_BAR_WORDS 3456
#define XB_SPIN_CAP (1u << 18)

__device__ __forceinline__ unsigned xb_ld(unsigned* p)              { return __hip_atomic_load(p, __ATOMIC_RELAXED, __HIP_MEMORY_SCOPE_AGENT); }
__device__ __forceinline__ unsigned xb_add(unsigned* p, unsigned v) { return __hip_atomic_fetch_add(p, v, __ATOMIC_RELAXED, __HIP_MEMORY_SCOPE_AGENT); }
__device__ __forceinline__ unsigned xb_xcc_id() { return (unsigned)__builtin_amdgcn_s_getreg((3 << 11) | 20) & 0xFu; }
#define XB_SPIN(cond, bar) do { unsigned _sp = 0; while (cond) { __builtin_amdgcn_s_sleep(1); \
    if ((++_sp & 255u) == 0u) { if (xb_ld(&(bar)[XB_TMO])) break; if (_sp > XB_SPIN_CAP) { atomicAdd(&(bar)[XB_TMO], 1u); break; } } } } while (0)

struct XcdBarrier {
    unsigned* bar; unsigned x;
    volatile LAS unsigned* st;
};

__device__ __forceinline__ XcdBarrier xcd_barrier_post(unsigned* bar, volatile LAS unsigned* st) {
    XcdBarrier b; b.bar = bar; b.x = xb_xcc_id(); b.st = st;
    if (threadIdx.x == 0) (void)xb_add(&bar[XB_XCNT(b.x)], 1u);
    return b;
}
__device__ __forceinline__ void xcd_barrier_complete(unsigned* bar, unsigned x, unsigned& nloc, unsigned& nx) {
    const unsigned G = gridDim.x * gridDim.y * gridDim.z;
    unsigned sum, cnt, mine, sp = 0u;
    for (;;) {
        sum = 0u; cnt = 0u; mine = 0u;
#pragma unroll
        for (unsigned j = 0; j < 16; ++j) { const unsigned c = xb_ld(&bar[XB_XCNT(j)]); sum += c; cnt += (c > 0u) ? 1u : 0u; mine = (j == x) ? c : mine; }
        if (sum == G) break;
        __builtin_amdgcn_s_sleep(1);
        if ((++sp & 255u) == 0u) { if (xb_ld(&bar[XB_TMO])) break; if (sp > XB_SPIN_CAP) { atomicAdd(&bar[XB_TMO], 1u); break; } }
    }
    nloc = mine > 0u ? mine : 1u; nx = cnt > 0u ? cnt : 1u;
}

__device__ __forceinline__ void xcd_barrier(const XcdBarrier& b) {
    asm volatile("s_waitcnt vmcnt(0)" ::: "memory");
    __syncthreads();
    if (threadIdx.x == 0) {
        unsigned* bar = b.bar;
        __builtin_amdgcn_s_waitcnt(0);
        unsigned nloc = b.st[0], nx = b.st[1];
        if (nloc == 0u) { xcd_barrier_complete(bar, b.x, nloc, nx); b.st[0] = nloc; b.st[1] = nx; }
        const unsigned old = xb_add(&bar[XB_XSUB(b.x)], 1u);
        const unsigned gen = old / nloc;
        if (old + 1u == (gen + 1u) * nloc) {
            __builtin_amdgcn_fence(__ATOMIC_RELEASE, "agent");
            asm volatile("s_waitcnt vmcnt(0)" ::: "memory");
            const unsigned og = xb_add(&bar[XB_TOP], 1u);
            const unsigned tg = og / nx;
            if (og + 1u == (tg + 1u) * nx) xb_add(&bar[XB_TOPGEN], 1u);
            else XB_SPIN(xb_ld(&bar[XB_TOPGEN]) == tg, bar);
            __builtin_amdgcn_fence(__ATOMIC_ACQUIRE, "agent");
            xb_add(&bar[XB_XGEN(b.x)], 1u);
            asm volatile("s_waitcnt vmcnt(0)" ::: "memory");
        } else {
            XB_SPIN(xb_ld(&bar[XB_XGEN(b.x)]) == gen, bar);
            __builtin_amdgcn_fence(__ATOMIC_ACQUIRE, "agent");
            asm volatile("s_waitcnt vmcnt(0)" ::: "memory");
        }
    }
    __syncthreads();
}
#ifndef REP_PRO
#define REP_PRO 1
#endif
#ifndef REP_P2
#define REP_P2 1
#endif
#ifndef REP_TL
#define REP_TL 1
#endif
#ifndef REP_PREP
#define REP_PREP 1
#endif
#ifndef REP_TR
#define REP_TR 1
#endif
#ifndef REP_ST
#define REP_ST 1
#endif
#ifndef REP_SC
#define REP_SC 1
#endif
#ifndef REP_OUT
#define REP_OUT 1
#endif
#ifndef REP_WIN
#define REP_WIN 1
#endif
#ifndef REP_MRG
#define REP_MRG 1
#endif
#ifndef REP_MOE
#define REP_MOE 1
#endif
#ifndef REP_N1
#define REP_N1 1
#endif
#ifndef REP_N2
#define REP_N2 1
#endif
#ifndef REP_SUM3
#define REP_SUM3 1
#endif
#ifndef REP_GM1
#define REP_GM1 1
#endif
#ifndef REP_GM2
#define REP_GM2 1
#endif
#ifndef REP_QW
#define REP_QW 1
#endif
#ifndef REP_FFN1
#define REP_FFN1 1
#endif
struct Args { const float* in[26]; float* out; unsigned char* ws; };
struct Wv { int tid, lane, wave, vcu, G, gw, NGW; };
#define WV_LOCAL(w0) Wv w = (w0); w.tid = threadIdx.x; asm volatile("" : "+v"(w.tid), "+s"(w.wave), "+s"(w.vcu), "+s"(w.gw), "+s"(w.G), "+s"(w.NGW)); w.lane = w.tid & 63

DEVI int srccol(int mode, int ff, int n) {
    if (mode == 0) return n;
    if (mode == 1) return n < 1280 ? n : n + 16;
    return (n >> 8) * 128 + (n & 127) + ((n & 128) ? ff : 0);
}
DEVI void tr_item(const float* W, int Nsrc, bf16* WT, int K, int k0, int n0, int mode, int ff, LAS unsigned char* scr, int lane) {
    const int c4 = lane & 15, kr = lane >> 4; const int sc = srccol(mode, ff, n0 + 4 * c4);
#pragma unroll 8
    for (int it = 0; it < 16; ++it) { const int k = it * 4 + kr; f32x4 v = {0.f, 0.f, 0.f, 0.f}; if (sc >= 0) v = *(const f32x4*)(W + (size_t)(k0 + k) * Nsrc + sc);
        v2u o; o.x = pk2(v.x, v.y); o.y = pk2(v.z, v.w); *(LAS v2u*)(scr + k * 136 + c4 * 8) = o; }
    LDS_WAIT(); asm volatile("" ::: "memory");
#pragma unroll 2
    for (int it = 0; it < 8; ++it) { const int q = it * 64 + lane, n = q >> 3, kg = q & 7; unsigned e[8];
#pragma unroll
        for (int i = 0; i < 8; ++i) { const unsigned wv = *(const LAS unsigned*)(scr + (kg * 8 + i) * 136 + (n >> 1) * 4); e[i] = (n & 1) ? (wv >> 16) : (wv & 0xffffu); }
        v4u o; o.x = e[0] | (e[1] << 16); o.y = e[2] | (e[3] << 16); o.z = e[4] | (e[5] << 16); o.w = e[6] | (e[7] << 16);
        *(v4u*)(WT + (size_t)(n0 + n) * K + k0 + kg * 8) = o; }
    LDS_WAIT(); asm volatile("" ::: "memory");
}
struct WqDesc { const float* W; unsigned char* WT; float* sc; float* pmax; int K, Nd, Nsrc, mode, ff; };
DEVI WqDesc wq_desc(const Args& A, unsigned char* ws, int set, int m) {
    WqDesc d;
    if (set == 0)      { d.W = A.in[20] + (size_t)m * 1024 * 5632; d.WT = ws + WS_W13 + (size_t)m * 5632 * 1024; d.sc = (float*)(ws + WS_SB13) + (size_t)m * 5632; d.pmax = (float*)(ws + WS_R) + 0 + (size_t)m * 5632 * 4; d.K = 1024; d.Nd = 5632; d.Nsrc = 5632; d.mode = 2; d.ff = FF; }
    else if (set == 1) { d.W = A.in[23] + (size_t)m * 1024 * 7168; d.WT = ws + WS_M13 + (size_t)m * 7168 * 1024; d.sc = (float*)(ws + WS_SBM) + (size_t)m * 7168; d.pmax = (float*)(ws + WS_R) + 45056 + (size_t)m * 7168 * 4; d.K = 1024; d.Nd = 7168; d.Nsrc = 7168; d.mode = 2; d.ff = EFF; }
    else if (set == 2) { d.W = A.in[8] + (size_t)m * 1024 * 6928; d.WT = ws + WS_WIN + (size_t)m * NP * 1024; d.sc = (float*)(ws + WS_SBW) + (size_t)m * NP; d.pmax = (float*)(ws + WS_R) + 503808 + (size_t)m * NP * 4; d.K = 1024; d.Nd = NP; d.Nsrc = 6928; d.mode = 1; d.ff = 0; }
    else if (set == 3) { d.W = A.in[19] + (size_t)m * 1024 * 1024; d.WT = ws + WS_WOUT + (size_t)m * 1024 * 1024; d.sc = (float*)(ws + WS_SBO) + (size_t)m * 1024; d.pmax = (float*)(ws + WS_R) + 618496 + (size_t)m * 1024 * 4; d.K = 1024; d.Nd = 1024; d.Nsrc = 1024; d.mode = 0; d.ff = 0; }
    else if (set == 4) { d.W = A.in[21] + (size_t)m * 2816 * 1024; d.WT = ws + WS_W2 + (size_t)m * 1024 * 2816; d.sc = (float*)(ws + WS_SB2) + (size_t)m * 1024; d.pmax = (float*)(ws + WS_R) + 634880 + (size_t)m * 1024 * 11; d.K = 2816; d.Nd = 1024; d.Nsrc = 1024; d.mode = 0; d.ff = 0; }
    else               { d.W = A.in[24] + (size_t)m * 3584 * 1024; d.WT = ws + WS_M2 + (size_t)m * 1024 * 3584; d.sc = (float*)(ws + WS_SBM2) + (size_t)m * 1024; d.pmax = (float*)(ws + WS_R) + 657408 + (size_t)m * 1024 * 14; d.K = 3584; d.Nd = 1024; d.Nsrc = 1024; d.mode = 0; d.ff = 0; }
    return d;
}
DEVI void wq_decode(int it, int kind, int& set, int& m, int& q) {
    const int nb[6] = {88, 112, 108, 16, 16, 16}, kb[6] = {16, 16, 16, 16, 44, 56}, nm[6] = {2, 16, 4, 4, 2, 16};
    int r = it;
#pragma unroll
    for (int s_ = 0; s_ < 6; ++s_) { const int per = kind == 1 ? nb[s_] * kb[s_] : nb[s_] * (kb[s_] / 4); const int tot = per * nm[s_]; if (r < tot || s_ == 5) { set = s_; m = r / per; q = r % per; return; } r -= tot; }
}
constexpr int WQ_NSLICE = (2 * 88 + 16 * 112 + 4 * 108 + 4 * 16) * 4 + 2 * 16 * 11 + 16 * 16 * 14;
constexpr int WQ_NITEM = 2 * 88 * 16 + 16 * 112 * 16 + 4 * 108 * 16 + 4 * 16 * 16 + 2 * 16 * 44 + 16 * 16 * 56;
DEVI void wq_colmax(const Args& A, const Wv& w) {
    unsigned char* ws = A.ws;
    for (int t = 9856 + w.gw; t < WQ_NSLICE; t += w.NGW) {
        int set, m, q; wq_decode(t, 2, set, m, q); const WqDesc d = wq_desc(A, ws, set, m);
        const int nbl = d.Nd / 64, nbk = q % nbl, ks = q / nbl;
        const int c4 = w.lane & 15, kr = w.lane >> 4, n = nbk * 64 + 4 * c4; const int sc0 = srccol(d.mode, d.ff, n); const float* wp = d.W + (sc0 >= 0 ? sc0 : 0) + (size_t)(ks * 256 + kr) * d.Nsrc; f32x4 m4 = {0.f, 0.f, 0.f, 0.f};
#pragma unroll 16
        for (int k = 0; k < 64; ++k) { const f32x4 v = *(const f32x4*)(wp + (size_t)(4 * k) * d.Nsrc); m4.x = fmaxf(m4.x, fabsf(v.x)); m4.y = fmaxf(m4.y, fabsf(v.y)); m4.z = fmaxf(m4.z, fabsf(v.z)); m4.w = fmaxf(m4.w, fabsf(v.w)); }
#pragma unroll
        for (int e = 0; e < 4; ++e) { m4[e] = fmaxf(m4[e], __shfl_xor(m4[e], 16)); m4[e] = fmaxf(m4[e], __shfl_xor(m4[e], 32)); }
        if (sc0 < 0) m4 = (f32x4){0.f, 0.f, 0.f, 0.f};
        if (kr == 0) *(f32x4*)(d.pmax + (size_t)ks * d.Nd + n) = m4;
    }
}
DEVI void ph_quant_w(const Args& A, LAS unsigned char* lds, const Wv& w0) {
    WV_LOCAL(w0);
    unsigned char* ws = A.ws; LAS unsigned char* scr = lds + w.wave * 4608;
    for (int it = 39424 + w.gw; it < WQ_NITEM; it += w.NGW) {
        int set, m, q; wq_decode(it, 1, set, m, q); const WqDesc d = wq_desc(A, ws, set, m);
        const int nbl = d.Nd / 64; const int k0 = (q / nbl) * 64, n0 = (q % nbl) * 64;
        const int c4 = w.lane & 15, kr = w.lane >> 4; const int scs = srccol(d.mode, d.ff, n0 + 4 * c4); const int sc = scs >= 0 ? scs : 0;
        f32x4 pm[14];
#pragma unroll
        for (int ks = 0; ks < 14; ++ks) { const int kc = ks < d.K / 256 ? ks : 0; pm[ks] = *(const f32x4*)(d.pmax + (size_t)kc * d.Nd + n0 + 4 * c4); }
        f32x4 m4 = pm[0];
#pragma unroll
        for (int ks = 1; ks < 14; ++ks) { m4.x = fmaxf(m4.x, pm[ks].x); m4.y = fmaxf(m4.y, pm[ks].y); m4.z = fmaxf(m4.z, pm[ks].z); m4.w = fmaxf(m4.w, pm[ks].w); }
        if (k0 == 0 && kr == 0) *(f32x4*)(d.sc + n0 + 4 * c4) = m4 * (1.0f / 224.0f);
        f32x4 inv;
#pragma unroll
        for (int e = 0; e < 4; ++e) inv[e] = m4[e] > 0.f ? 224.0f / m4[e] : 0.f;
#pragma unroll 8
        for (int i = 0; i < 16; ++i) { const int k = i * 4 + kr; const f32x4 v = *(const f32x4*)(d.W + (size_t)(k0 + k) * d.Nsrc + sc);
            int pq = __builtin_amdgcn_cvt_pk_fp8_f32(v.x * inv.x, v.y * inv.y, 0, false); pq = __builtin_amdgcn_cvt_pk_fp8_f32(v.z * inv.z, v.w * inv.w, pq, true);
            *(LAS unsigned*)(scr + k * 68 + c4 * 4) = (unsigned)pq; }
        LDS_WAIT(); asm volatile("" ::: "memory");
#pragma unroll 2
        for (int i = 0; i < 4; ++i) { const int p = i * 64 + w.lane, n = p >> 2, kg = p & 3; unsigned o[4];
#pragma unroll
            for (int dd = 0; dd < 4; ++dd) { unsigned v = 0;
#pragma unroll
                for (int b = 0; b < 4; ++b) v |= (unsigned)scr[(kg * 16 + dd * 4 + b) * 68 + n] << (8 * b);
                o[dd] = v; }
            v4u ov; ov.x = o[0]; ov.y = o[1]; ov.z = o[2]; ov.w = o[3];
            *(v4u*)(d.WT + (size_t)(n0 + n) * d.K + k0 + kg * 16) = ov; }
        LDS_WAIT(); asm volatile("" ::: "memory");
    }
}

template <int W>
DEVI void ph_quant_act(const bf16* src, unsigned char* dst, float* scale, int row_start, int row_end, const Wv& w0) {
    WV_LOCAL(w0);
    constexpr int NV = W / 8, NI = (NV + 63) / 64;
    for (int row = row_start + w.gw; row < row_end; row += w.NGW) {
        v4u v[NI]; float am = 0.f;
#pragma unroll
        for (int i = 0; i < NI; ++i) { const int vi = i * 64 + w.lane; v[i] = (v4u){0u, 0u, 0u, 0u}; if (vi < NV) v[i] = *(const v4u*)(src + (size_t)row * W + vi * 8); }
#pragma unroll
        for (int i = 0; i < NI; ++i) { float f[8]; unpack8(v[i], f);
#pragma unroll
            for (int e = 0; e < 8; ++e) am = fmaxf(am, fabsf(f[e])); }
#pragma unroll
        for (int o = 1; o < 64; o <<= 1) am = fmaxf(am, __shfl_xor(am, o));
        const float inv = am > 0.f ? 127.0f / am : 0.f;
#pragma unroll
        for (int i = 0; i < NI; ++i) { const int vi = i * 64 + w.lane; if (vi < NV) { float f[8]; unpack8(v[i], f); int qv[8];
#pragma unroll
                for (int e = 0; e < 8; ++e) qv[e] = (int)rintf(f[e] * inv) & 255;
                v2u o; o.x = (unsigned)qv[0] | ((unsigned)qv[1] << 8) | ((unsigned)qv[2] << 16) | ((unsigned)qv[3] << 24); o.y = (unsigned)qv[4] | ((unsigned)qv[5] << 8) | ((unsigned)qv[6] << 16) | ((unsigned)qv[7] << 24);
                *(v2u*)(dst + (size_t)row * W + vi * 8) = o; } }
        if (w.lane == 0) scale[row] = am * (1.0f / 127.0f);
    }
}

DEVI void wq_single(const Args& A, LAS unsigned char* lds, const Wv& w) {
    unsigned char* ws = A.ws; LAS float* tile = (LAS float*)lds; LAS float* pm = (LAS float*)(lds + 135168); LAS float* mx = pm + 512;
    for (int t0 = w.vcu; t0 < 4928; t0 += w.G) {
        int t = t0, set, m, nb;
        if (t < 352) { set = 0; m = t / 176; nb = t % 176; } else if ((t -= 352) < 3584) { set = 1; m = t / 224; nb = t % 224; } else if ((t -= 3584) < 864) { set = 2; m = t / 216; nb = t % 216; } else { t -= 864; set = 3; m = t / 32; nb = t % 32; }
        const WqDesc d = wq_desc(A, ws, set, m); const int n0 = nb * 32;
        { const int c4 = w.tid & 7; const int sc0 = srccol(d.mode, d.ff, n0 + 4 * c4); const float* wp = d.W + (sc0 >= 0 ? sc0 : 0);
#pragma unroll 8
          for (int it = 0; it < 16; ++it) { const int k = it * 64 + (w.tid >> 3); f32x4 v = *(const f32x4*)(wp + (size_t)k * d.Nsrc); if (sc0 < 0) v = (f32x4){0.f, 0.f, 0.f, 0.f};
            LAS float* tp = tile + k * 33 + 4 * c4; tp[0] = v.x; tp[1] = v.y; tp[2] = v.z; tp[3] = v.w; } }
        __syncthreads();
        const int n = w.tid & 31, sl = w.tid >> 5;
        { float a = 0.f;
#pragma unroll 16
          for (int i = 0; i < 64; ++i) a = fmaxf(a, fabsf(tile[(sl * 64 + i) * 33 + n]));
          pm[sl * 32 + n] = a; }
        __syncthreads();
        if (w.tid < 32) { float a = pm[w.tid];
#pragma unroll
            for (int q = 1; q < 16; ++q) a = fmaxf(a, pm[q * 32 + w.tid]);
            mx[w.tid] = a; d.sc[n0 + w.tid] = a * (1.0f / 127.0f); }
        __syncthreads();
        { const float a = mx[n]; const float inv = a > 0.f ? 127.0f / a : 0.f; unsigned char* op = d.WT + (size_t)(n0 + n) * 1024 + sl * 64;
#pragma unroll
          for (int p = 0; p < 4; ++p) { unsigned o[4];
#pragma unroll
            for (int dd = 0; dd < 4; ++dd) { unsigned v = 0;
#pragma unroll
                for (int b = 0; b < 4; ++b) v |= ((unsigned)((int)rintf(tile[(sl * 64 + p * 16 + dd * 4 + b) * 33 + n] * inv) & 255)) << (8 * b);
                o[dd] = v; }
            v4u ov; ov.x = o[0]; ov.y = o[1]; ov.z = o[2]; ov.w = o[3]; *(v4u*)(op + p * 16) = ov; } }
        __syncthreads();
    }
}
DEVI void ph_prologue(const Args& A, LAS unsigned char* lds, const Wv& w0) {
    WV_LOCAL(w0);
    unsigned char* ws = A.ws;
    LAS float* sc = (LAS float*)lds;
    for (int i = w.tid; i < 5 * 1024; i += 512) { const int v = i >> 10, k = i & 1023; const float c = v < 4 ? A.in[1][v * 1024 + k] : A.in[3][k]; sc[i] = silu_f(c); }
    __syncthreads();
    float* MOD = (float*)(ws + WS_MOD);
    for (int u = w.gw; u < 1536; u += w.NGW) { const int layer = u / 384, c = w.lane & 15, kq = w.lane >> 4, col = (u % 384) * 16 + c;
        const float* wp = A.in[4] + (size_t)layer * 1024 * 6144 + (size_t)(kq * 256) * 6144 + col; const LAS float* sk = sc + kq * 256; float a0 = 0.f, a1 = 0.f, a2 = 0.f, a3 = 0.f, a4 = 0.f;
#pragma unroll 16
        for (int k = 0; k < 256; ++k) { const float wv = wp[(size_t)k * 6144]; a0 += sk[k] * wv; a1 += sk[1024 + k] * wv; a2 += sk[2048 + k] * wv; a3 += sk[3072 + k] * wv; a4 += sk[4096 + k] * wv; }
        a0 += __shfl_xor(a0, 16); a1 += __shfl_xor(a1, 16); a2 += __shfl_xor(a2, 16); a3 += __shfl_xor(a3, 16); a4 += __shfl_xor(a4, 16);
        a0 += __shfl_xor(a0, 32); a1 += __shfl_xor(a1, 32); a2 += __shfl_xor(a2, 32); a3 += __shfl_xor(a3, 32); a4 += __shfl_xor(a4, 32);
        if (kq == 0) { const float b = A.in[5][layer * 6144 + col]; float* m = MOD + (size_t)layer * 5 * 6144 + col;
            m[0] = a0 + b; m[6144] = a1 + b; m[2 * 6144] = a2 + b; m[3 * 6144] = a3 + b; m[4 * 6144] = a4 + b; } }
    if (w.gw < 48) { const int e = w.gw * 64 + w.lane, pos = e >> 4, ai = e & 15; const float inv = powf(10000.0f, -(float)ai * (1.0f / 16.0f)); const float ang = (float)(pos < 128 ? pos : pos - 128) * inv; float sn, cs_; sincosf(ang, &sn, &cs_);
        ((float*)(ws + WS_ROPE))[2 * e] = cs_; ((float*)(ws + WS_ROPE))[2 * e + 1] = sn; }
    LAS unsigned char* scr = lds + 32768 + w.wave * 8704;
    constexpr int N0 = 0, N1 = 1024, N2 = 0, N3 = 0, N4 = 0, N5 = 0, N6 = 0, NITEMS = N0 + N1 + N2 + N3 + N4 + N5 + N6;
    for (int it = w.gw; it < NITEMS; it += w.NGW) {
        int r = it; const float* W; bf16* WT; int Nsrc, K, k0, n0, mode = 0, ff = 0;
        if (r < N0) { const int layer = r / 1792, q = r % 1792; W = A.in[8] + (size_t)layer * 1024 * 6928; Nsrc = 6928; WT = (bf16*)(ws + WS_WIN) + (size_t)layer * NP * 1024; K = 1024; k0 = (q / 112) * 64; n0 = (q % 112) * 64; mode = 1; }
        else if ((r -= N0) < N1) { const int m = r / 128, layer = m >> 1, i = (m & 1) * 2, q = r % 128; W = A.in[18] + (size_t)(layer * 3 + i) * 512 * 1024; Nsrc = 1024; WT = (bf16*)(ws + WS_WBR) + (size_t)(layer * 3 + i) * 1024 * 512; K = 512; k0 = (q / 16) * 64; n0 = (q % 16) * 64; }
        else if ((r -= N1) < N2) { const int layer = r / 256, q = r % 256; W = A.in[19] + (size_t)layer * 1024 * 1024; Nsrc = 1024; WT = (bf16*)(ws + WS_WOUT) + (size_t)layer * 1024 * 1024; K = 1024; k0 = (q / 16) * 64; n0 = (q % 16) * 64; }
        else if ((r -= N2) < N3) { const int l2 = r / 1408, q = r % 1408; W = A.in[20] + (size_t)l2 * 1024 * 5632; Nsrc = 5632; WT = (bf16*)(ws + WS_W13) + (size_t)l2 * 5632 * 1024; K = 1024; k0 = (q / 88) * 64; n0 = (q % 88) * 64; mode = 2; ff = FF; }
        else if ((r -= N3) < N4) { const int l2 = r / 704, q = r % 704; W = A.in[21] + (size_t)l2 * 2816 * 1024; Nsrc = 1024; WT = (bf16*)(ws + WS_W2) + (size_t)l2 * 1024 * 2816; K = 2816; k0 = (q / 16) * 64; n0 = (q % 16) * 64; }
        else if ((r -= N4) < N5) { const int m = r / 1792, q = r % 1792; W = A.in[23] + (size_t)m * 1024 * 7168; Nsrc = 7168; WT = (bf16*)(ws + WS_M13) + (size_t)m * 7168 * 1024; K = 1024; k0 = (q / 112) * 64; n0 = (q % 112) * 64; mode = 2; ff = EFF; }
        else { r -= N5; const int m = r / 896, q = r % 896; W = A.in[24] + (size_t)m * 3584 * 1024; Nsrc = 1024; WT = (bf16*)(ws + WS_M2) + (size_t)m * 1024 * 3584; K = 3584; k0 = (q / 16) * 64; n0 = (q % 16) * 64; }
        tr_item(W, Nsrc, WT, K, k0, n0, mode, ff, scr, w.lane);
    }
    wq_colmax(A, w);
    if (w.gw < DEPTH * 16) { const int layer = w.gw >> 4, j = w.gw & 15; const float* wp = A.in[8] + (size_t)layer * 1024 * 6928 + 1280 + j; float v[16], am = 0.f;
#pragma unroll
        for (int i = 0; i < 16; ++i) { v[i] = wp[(size_t)(w.lane * 16 + i) * 6928]; am = fmaxf(am, fabsf(v[i])); }
#pragma unroll
        for (int o = 1; o < 64; o <<= 1) am = fmaxf(am, __shfl_xor(am, o));
        const float inv = am > 0.f ? 127.0f / am : 0.f; unsigned q4[4];
#pragma unroll
        for (int d4 = 0; d4 < 4; ++d4) { unsigned q = 0;
#pragma unroll
            for (int b = 0; b < 4; ++b) q |= ((unsigned)((int)rintf(v[d4 * 4 + b] * inv) & 255)) << (8 * b);
            q4[d4] = q; }
        v4u ov; ov.x = q4[0]; ov.y = q4[1]; ov.z = q4[2]; ov.w = q4[3];
        *(v4u*)(ws + WS_WDT8 + ((size_t)(layer * 16 + j)) * 1024 + w.lane * 16) = ov;
        if (w.lane == 0) ((float*)(ws + WS_SBDT))[layer * 16 + j] = am * (1.0f / 127.0f); }
    for (int it = w.gw; it < 4096; it += w.NGW) {
        const int layer = it >> 10, r = it & 1023, gi = r >> 8, ib = (r >> 4) & 15, db = r & 15, d = db * 64 + w.lane, i0 = ib * 8;
        const float* pw = A.in[15] + ((size_t)(layer * 4 + gi) * 128 + i0) * 128; const float* ps = A.in[16] + layer * 512 + gi * 128;
        const float* wb = A.in[18] + ((size_t)(layer * 3 + 1) * 512 + gi * 128) * 1024 + d;
        float acc[8] = {0.f, 0.f, 0.f, 0.f, 0.f, 0.f, 0.f, 0.f};
#pragma unroll 16
        for (int j = 0; j < 128; ++j) { const float wv = wb[(size_t)j * 1024] * ps[j];
#pragma unroll
            for (int i = 0; i < 8; ++i) acc[i] += pw[i * 128 + j] * wv; }
        *(v4u*)((bf16*)(ws + WS_WBR) + ((size_t)(layer * 3 + 1) * 1024 + d) * 512 + gi * 128 + i0) = pack8(acc);
    }
    __syncthreads();
    wq_single(A, lds, w);
}

template <int MODE, bool COMBINE, bool ROUTER, bool Q8 = false>
DEVI void ph_norm(const Args& A, const Wv& w0, int layer, int prev, int row_start = 0, bool from_inputs = false) {
    WV_LOCAL(w0);
    unsigned char* ws = A.ws;
    bf16* X = (bf16*)(ws + WS_X); bf16* ABF = (bf16*)(ws + WS_ABF); const float* MOD = (const float*)(ws + WS_MOD);
    const float* YB = (const float*)(ws + WS_YB); const v4i* ROUTE = (const v4i*)(ws + WS_ROUTE); const v2i* SLOT = (const v2i*)(ws + WS_SLOT);
    f32x4 rw[ROUTER ? 4 : 1][4][2];
    if (ROUTER) { const float* wr = A.in[22] + (size_t)(layer >> 1) * D * 8;
#pragma unroll
        for (int j = 0; j < 4; ++j)
#pragma unroll
            for (int i = 0; i < 4; ++i) { const int col = j * 256 + w.lane * 4 + i; rw[ROUTER ? j : 0][i][0] = *(const f32x4*)(wr + col * 8); rw[ROUTER ? j : 0][i][1] = *(const f32x4*)(wr + col * 8 + 4); } }
    f32x4 gnv[4], shv[4], scv[4], g2v[4]; int vcur = -1;
    { const float* gn = (MODE == 2 ? A.in[25] : A.in[MODE == 0 ? 6 : 7] + layer * D) + w.lane * 4;
#pragma unroll
      for (int j = 0; j < 4; ++j) { gnv[j] = *(const f32x4*)(gn + j * 256); shv[j] = gnv[j]; scv[j] = gnv[j]; g2v[j] = gnv[j]; } }
#pragma unroll 2
    for (int row = row_start + w.gw; row < T; row += w.NGW) {
        if (MODE == 2 && row < NCTX) continue;
        const int v = row < NCTX ? 4 : ((row - NCTX) >> 13);
        if (v != vcur) { vcur = v;
            if (MODE != 2) { const float* md = MOD + ((size_t)layer * 5 + v) * 6144 + (MODE == 0 ? 0 : 3072) + w.lane * 4;
#pragma unroll
                for (int j = 0; j < 4; ++j) { shv[j] = *(const f32x4*)(md + j * 256); scv[j] = *(const f32x4*)(md + 1024 + j * 256); } }
            if (COMBINE) { const float* g2 = MOD + ((size_t)prev * 5 + v) * 6144 + 5120 + w.lane * 4;
#pragma unroll
                for (int j = 0; j < 4; ++j) g2v[j] = *(const f32x4*)(g2 + j * 256); } }
        bf16* xr = X + (size_t)row * D + w.lane * 4;
        f32x4 xv[4];
        if (from_inputs) {
            const float* xs = (row < NCTX ? A.in[2] + (size_t)row * D : A.in[0] + (size_t)(row - NCTX) * D) + w.lane * 4;
#pragma unroll
            for (int j = 0; j < 4; ++j) xv[j] = *(const f32x4*)(xs + j * 256);
        } else {
            v2u xw[4];
#pragma unroll
            for (int j = 0; j < 4; ++j) xw[j] = *(const v2u*)(xr + j * 256);
#pragma unroll
            for (int j = 0; j < 4; ++j) { xv[j].x = bfl(xw[j].x); xv[j].y = bfh(xw[j].x); xv[j].z = bfl(xw[j].y); xv[j].w = bfh(xw[j].y); }
        }
        if (COMBINE) {
            const v4i rt = ROUTE[row]; const v2i sl = SLOT[row]; const float w0 = __int_as_float(rt.z), w1 = __int_as_float(rt.w);
            const bf16* y0 = (const bf16*)YB + (size_t)sl.x * D + w.lane * 4; const bf16* y1 = (const bf16*)YB + (size_t)sl.y * D + w.lane * 4;
#pragma unroll
            for (int j = 0; j < 4; ++j) { const v2u aw = *(const v2u*)(y0 + j * 256), bw = *(const v2u*)(y1 + j * 256); const f32x4 a = {bfl(aw.x), bfh(aw.x), bfl(aw.y), bfh(aw.y)}, b = {bfl(bw.x), bfh(bw.x), bfl(bw.y), bfh(bw.y)}, g = g2v[j];
                xv[j] = xv[j] + g * (a * w0 + b * w1); if (MODE != 2) { v2u o; o.x = pk2(xv[j].x, xv[j].y); o.y = pk2(xv[j].z, xv[j].w); *(v2u*)(xr + j * 256) = o; } }
        }
        float ss = 0.f;
#pragma unroll
        for (int j = 0; j < 4; ++j) ss += (xv[j].x * xv[j].x + xv[j].y * xv[j].y) + (xv[j].z * xv[j].z + xv[j].w * xv[j].w);
        ss = wave_sum(ss);
        const float r = 1.0f / sqrtf(ss * (1.0f / D) + EPS);
        if (MODE == 2) {
            float* o = A.out + (size_t)(row - NCTX) * D + w.lane * 4;
#pragma unroll
            for (int j = 0; j < 4; ++j) *(f32x4*)(o + j * 256) = xv[j] * r * gnv[j];
            continue;
        }
        f32x4 h[4];
#pragma unroll
        for (int j = 0; j < 4; ++j) { const f32x4 g = gnv[j], sh = shv[j], sc = scv[j];
            h[j] = (xv[j] * r * g) * (sc + 1.0f) + sh;
            if (!Q8) { v2u o; o.x = pk2(h[j].x, h[j].y); o.y = pk2(h[j].z, h[j].w); *(v2u*)(ABF + (size_t)row * D + j * 256 + w.lane * 4) = o; } }
        if (Q8) {
            float am = 0.f;
#pragma unroll
            for (int j = 0; j < 4; ++j) am = fmaxf(fmaxf(am, fmaxf(fabsf(h[j].x), fabsf(h[j].y))), fmaxf(fabsf(h[j].z), fabsf(h[j].w)));
#pragma unroll
            for (int o = 1; o < 64; o <<= 1) am = fmaxf(am, __shfl_xor(am, o));
            const float inv = am > 0.f ? 127.0f / am : 0.f;
#pragma unroll
            for (int j = 0; j < 4; ++j) { const int q0 = (int)rintf(h[j].x * inv), q1 = (int)rintf(h[j].y * inv), q2 = (int)rintf(h[j].z * inv), q3 = (int)rintf(h[j].w * inv);
                *(unsigned*)((unsigned char*)ABF + (size_t)row * D + j * 256 + w.lane * 4) = (unsigned)(q0 & 255) | ((unsigned)(q1 & 255) << 8) | ((unsigned)(q2 & 255) << 16) | ((unsigned)(q3 & 255) << 24); }
            if (w.lane == 0) ((float*)(ws + WS_SA))[row] = am * (1.0f / 127.0f);
        }
        if (ROUTER) {
            float lg[8] = {0.f, 0.f, 0.f, 0.f, 0.f, 0.f, 0.f, 0.f};
#pragma unroll
            for (int j = 0; j < 4; ++j)
#pragma unroll
                for (int i = 0; i < 4; ++i) { const f32x4 wa = rw[ROUTER ? j : 0][i][0], wb = rw[ROUTER ? j : 0][i][1]; const float hv = h[j][i];
                    lg[0] += hv * wa.x; lg[1] += hv * wa.y; lg[2] += hv * wa.z; lg[3] += hv * wa.w; lg[4] += hv * wb.x; lg[5] += hv * wb.y; lg[6] += hv * wb.z; lg[7] += hv * wb.w; }
#pragma unroll
            for (int e = 0; e < 8; ++e) lg[e] = wave_sum(lg[e]);
            int e0 = 0; float v0 = lg[0];
#pragma unroll
            for (int e = 1; e < 8; ++e) if (lg[e] > v0) { v0 = lg[e]; e0 = e; }
            int e1 = -1; float v1 = -3.0e38f;
#pragma unroll
            for (int e = 0; e < 8; ++e) if (e != e0 && lg[e] > v1) { v1 = lg[e]; e1 = e; }
            const float ex = __expf(v1 - v0), w0 = 1.0f / (1.0f + ex), w1 = ex / (1.0f + ex);
            if (w.lane == 0) { v4i rt; rt.x = e0; rt.y = e1; rt.z = __float_as_int(w0); rt.w = __float_as_int(w1); ((v4i*)(ws + WS_ROUTE))[row] = rt; }
        }
    }
}

DEVI void seq_of_row(int row, int& base, int& t, int& L) { if (row < NCTX) { base = row & ~(CTXL - 1); t = row & (CTXL - 1); L = CTXL; } else { const int q = row - NCTX; base = NCTX + (q & ~(SEQ - 1)); t = q & (SEQ - 1); L = SEQ; } }
DEVI void ph_prep(const Args& A, const Wv& w0, int layer) {
    WV_LOCAL(w0);
    unsigned char* ws = A.ws; const bf16* P = (const bf16*)(ws + WS_P);
    const int gt = w.gw * 64 + w.lane, NT_ = w.NGW * 64;
    { bf16* XBC = (bf16*)(ws + WS_XBC); const float* cw = A.in[9] + (size_t)layer * 5 * 768; const float* cb = A.in[10] + layer * 768;
#pragma unroll 4
      for (int it = gt; it < T * 96; it += NT_) { const int row = it / 96, c = (it % 96) * 8; int base, t, L; seq_of_row(row, base, t, L);
        float acc[8];
#pragma unroll
        for (int i = 0; i < 8; ++i) acc[i] = cb[c + i];
#pragma unroll
        for (int k = 0; k < 5; ++k) { const int tt = t + k - 2; if (tt >= 0 && tt < L) { float u[8]; unpack8(*(const v4u*)(P + (size_t)(base + tt) * PS + PC_XBC + c), u);
#pragma unroll
            for (int i = 0; i < 8; ++i) acc[i] += cw[k * 768 + c + i] * u[i]; } }
#pragma unroll
        for (int i = 0; i < 8; ++i) acc[i] = silu_f(acc[i]);
        *(v4u*)(XBC + (size_t)row * 768 + c) = pack8(acc); } }
    { float* DTT = (float*)(ws + WS_DTT); const float* db = A.in[11] + layer * 16;
#pragma unroll 4
      for (int it = gt; it < NCID * 16 * 128; it += NT_) { const int l = it & 127, j = (it >> 7) & 15, cid = it >> 11; const int b = cid / NCH, c = cid % NCH; const int row = (c < 2 ? b * CTXL + c * 128 : NCTX + b * SEQ + (c - 2) * 128) + l;
        const float x = __uint_as_float((unsigned)P[(size_t)row * PS + PC_DT + j] << 16) + db[j];
        DTT[it] = x > 20.f ? x : log1pf(expf(x)); } }
    { bf16* QR = (bf16*)(ws + WS_QR); bf16* KR = (bf16*)(ws + WS_KR);
#pragma unroll 4
      for (int it = gt; it < T * 64; it += NT_) { const int row = it >> 6, r = it & 63, which = r >> 5, h = (r >> 2) & 7, pv = r & 3;
        const bf16* src = P + (size_t)row * PS + (which ? PC_K : PC_Q) + h * 64 + pv * 8; float x1[8], x2[8], o1[8], o2[8]; unpack8(*(const v4u*)src, x1); unpack8(*(const v4u*)(src + 32), x2);
        const float scl = which ? 0.125f : 1.0f;
        if (row >= NCTX) { const int t = (row - NCTX) & (SEQ - 1); const int pos = (pv < 2) ? (t >> 6) : 128 + (t & 63);
            const float* tab = (const float*)(ws + WS_ROPE) + ((size_t)pos * 16 + (pv & 1) * 8) * 2;
#pragma unroll
            for (int i = 0; i < 8; i += 2) { const f32x4 cs4 = *(const f32x4*)(tab + 2 * i);
                o1[i] = (x1[i] * cs4.x - x2[i] * cs4.y) * scl; o2[i] = (x1[i] * cs4.y + x2[i] * cs4.x) * scl; o1[i + 1] = (x1[i + 1] * cs4.z - x2[i + 1] * cs4.w) * scl; o2[i + 1] = (x1[i + 1] * cs4.w + x2[i + 1] * cs4.z) * scl; } }
        else {
#pragma unroll
            for (int i = 0; i < 8; ++i) { o1[i] = x1[i] * scl; o2[i] = x2[i] * scl; } }
        bf16* dst = (which ? KR : QR) + (size_t)row * 512 + h * 64 + pv * 8; *(v4u*)dst = pack8(o1); *(v4u*)(dst + 32) = pack8(o2); } }
    { bf16* AB1 = (bf16*)(ws + WS_ABR) + (size_t)T * 512;
#pragma unroll 2
      for (int it = gt; it < T * 64; it += NT_) { const int row = it >> 6, c = (it & 63) * 8, gi = c >> 7, wd = 2 << gi, left = wd >> 1, right = wd - 1 - left; int base, t, L; seq_of_row(row, base, t, L);
        const int lo = t - left > 0 ? t - left : 0, hi = t + right < L - 1 ? t + right : L - 1;
        float s[8] = {0.f, 0.f, 0.f, 0.f, 0.f, 0.f, 0.f, 0.f}, u0[8];
        v4u uw[16];
#pragma unroll
        for (int k = 0; k < 16; ++k) { const int tt = t - 8 + k; const int tc = tt < lo ? lo : (tt > hi ? hi : tt); uw[k] = *(const v4u*)(P + (size_t)(base + tc) * PS + PC_POOL + c); }
#pragma unroll
        for (int k = 0; k < 16; ++k) { const int tt = t - 8 + k; if (tt >= lo && tt <= hi) { float u[8]; unpack8(uw[k], u);
#pragma unroll
                for (int i = 0; i < 8; ++i) s[i] += u[i]; } }
        unpack8(uw[8], u0); const float rc = 1.0f / (float)(hi - lo + 1);
#pragma unroll
        for (int i = 0; i < 8; ++i) s[i] = s[i] * rc - u0[i];
        *(v4u*)(AB1 + (size_t)row * 512 + c) = pack8(s); } }
}
DEVI void ph_prep2(const Args& A, const Wv& w0, int layer) {
    WV_LOCAL(w0);
    unsigned char* ws = A.ws; const bf16* P = (const bf16*)(ws + WS_P);
    const int gt = w.gw * 64 + w.lane, NT_ = w.NGW * 64;
    { float* DTT = (float*)(ws + WS_DTT); const float* db = A.in[11] + layer * 16; const unsigned char* H8 = ws + WS_ABF; const unsigned char* W8 = ws + WS_WDT8 + (size_t)layer * 16 * 1024;
      const float* SAr = (const float*)(ws + WS_SA); const float* SBd = (const float*)(ws + WS_SBDT) + layer * 16; const int r = w.lane & 15, g = w.lane >> 4;
      for (int task = w.gw; task < NCID * 8; task += w.NGW) { const int cid = task >> 3, lg = task & 7; const int b = cid / NCH, c = cid % NCH; const int row0 = (c < 2 ? b * CTXL + c * 128 : NCTX + b * SEQ + (c - 2) * 128) + 16 * lg;
        v4i wa[16], hb[16];
#pragma unroll
        for (int kk = 0; kk < 16; ++kk) { wa[kk] = *(const v4i*)(W8 + (size_t)r * 1024 + 64 * kk + 16 * g); hb[kk] = *(const v4i*)(H8 + (size_t)(row0 + r) * 1024 + 64 * kk + 16 * g); }
        const float sa = SAr[row0 + r];
        v4i acc = {0, 0, 0, 0};
#pragma unroll
        for (int kk = 0; kk < 16; ++kk) acc = __builtin_amdgcn_mfma_i32_16x16x64_i8(wa[kk], hb[kk], acc, 0, 0, 0);
#pragma unroll
        for (int i = 0; i < 4; ++i) { const int j = 4 * g + i; const float x = (float)acc[i] * (sa * SBd[j]) + db[j];
            DTT[((size_t)cid * 16 + j) * 128 + 16 * lg + r] = x > 20.f ? x : log1pf(expf(x)); } } }
    { bf16* AB1 = (bf16*)(ws + WS_ABR) + (size_t)T * 512;
      v4u uw[16];
      auto issue = [&](int it) { const int row = it >> 6, c = (it & 63) * 8, gi = c >> 7, wd = 2 << gi, left = wd >> 1, right = wd - 1 - left; int base, t, L; seq_of_row(row, base, t, L);
          const int lo = t - left > 0 ? t - left : 0, hi = t + right < L - 1 ? t + right : L - 1;
#pragma unroll
          for (int k = 0; k < 16; ++k) { const int tt = t - 8 + k; const int tc = tt < lo ? lo : (tt > hi ? hi : tt); uw[k] = *(const v4u*)(P + (size_t)(base + tc) * PS + PC_POOL + c); } };
      int it = gt; if (it < T * 64) issue(it);
#pragma unroll 1
      for (; it < T * 64; it += NT_) { const int row = it >> 6, c = (it & 63) * 8, gi = c >> 7, wd = 2 << gi, left = wd >> 1, right = wd - 1 - left; int base, t, L; seq_of_row(row, base, t, L);
        const int lo = t - left > 0 ? t - left : 0, hi = t + right < L - 1 ? t + right : L - 1;
        float s[8] = {0.f, 0.f, 0.f, 0.f, 0.f, 0.f, 0.f, 0.f}, u0[8];
#pragma unroll
        for (int k = 0; k < 16; ++k) { const int tt = t - 8 + k; if (tt >= lo && tt <= hi) { float u[8]; unpack8(uw[k], u);
#pragma unroll
                for (int i = 0; i < 8; ++i) s[i] += u[i]; } }
        unpack8(uw[8], u0); const float rc = 1.0f / (float)(hi - lo + 1);
#pragma unroll
        for (int i = 0; i < 8; ++i) s[i] = s[i] * rc - u0[i];
        asm volatile("" ::: "memory");
        if (it + NT_ < T * 64) issue(it + NT_);
        asm volatile("" ::: "memory");
        *(v4u*)(AB1 + (size_t)row * 512 + c) = pack8(s); } }
}

typedef short bf16x8 __attribute__((ext_vector_type(8)));
typedef float f32x16 __attribute__((ext_vector_type(16)));
#define MFMA32(a, b, c) __builtin_amdgcn_mfma_f32_32x32x16_bf16((a), (b), (c), 0, 0, 0)
DEVI int chunk_row0(int cid) { const int b = cid / NCH, c = cid % NCH; return c < 2 ? b * CTXL + c * 128 : NCTX + b * SEQ + (c - 2) * 128; }
DEVI bf16x8 ld8(const bf16* p) { return __builtin_bit_cast(bf16x8, *(const v4u*)p); }
DEVI bf16x8 ld4x2(const bf16* p0, const bf16* p1) { const v2u a = *(const v2u*)p0, b = *(const v2u*)p1; v4u w; w.x = a.x; w.y = a.y; w.z = b.x; w.w = b.y; return __builtin_bit_cast(bf16x8, w); }

DEVI void ph_transpose(const Args& A, LAS unsigned char* lds, const Wv& w0) {
    WV_LOCAL(w0);
    unsigned char* ws = A.ws;
    LAS unsigned* tile = (LAS unsigned*)(lds + w.wave * 16896);
    for (int task = w.gw; task < NCID * 46; task += w.NGW) {
        const int cid = task / 46, m = task % 46, row0 = chunk_row0(cid);
        const bf16* src; int stride; bool typeX;
        if (m < 2) { src = (const bf16*)(ws + WS_XBC) + (size_t)row0 * 768 + 640 + m * 64; stride = 768; typeX = false; }
        else if (m < 6) { src = (const bf16*)(ws + WS_XBC) + (size_t)row0 * 768 + 512 + (m & 1) * 64; stride = 768; typeX = m >= 4; }
        else if (m < 14) { src = (const bf16*)(ws + WS_XBC) + (size_t)row0 * 768 + (m - 6) * 64; stride = 768; typeX = true; }
        else if (m < 22) { src = (const bf16*)(ws + WS_QR) + (size_t)row0 * 512 + (m - 14) * 64; stride = 512; typeX = false; }
        else if (m < 38) { src = (const bf16*)(ws + WS_KR) + (size_t)row0 * 512 + ((m - 22) & 7) * 64; stride = 512; typeX = m >= 30; }
        else { src = (const bf16*)(ws + WS_P) + (size_t)row0 * PS + PC_V + (m - 38) * 64; stride = PS; typeX = true; }
        bf16* dst = (bf16*)(ws + WS_FR) + ((size_t)cid * 46 + m) * 8192;
        if (!typeX) {
#pragma unroll 4
            for (int it = 0; it < 16; ++it) { const int q = it * 64 + w.lane, row = q >> 3, pc = q & 7; const v4u v = *(const v4u*)(src + (size_t)row * stride + pc * 8);
                *(v4u*)(dst + ((((row >> 5) * 4 + (pc >> 1)) * 64) + (pc & 1) * 32 + (row & 31)) * 8) = v; }
        } else {
#pragma unroll 4
            for (int it = 0; it < 16; ++it) { const int q = it * 64 + w.lane, row = q >> 3, pc = q & 7; const v4u v = *(const v4u*)(src + (size_t)row * stride + pc * 8);
                LAS unsigned* t = tile + row * 33 + pc * 4; t[0] = v.x; t[1] = v.y; t[2] = v.z; t[3] = v.w; }
            LDS_WAIT(); asm volatile("" ::: "memory");
#pragma unroll 2
            for (int it = 0; it < 16; ++it) {
                const int ct = it >> 3, i = (it >> 1) & 3, kk = it & 1, r = w.lane & 31, hh = w.lane >> 5, col = 32 * ct + r, rb = 32 * i + 16 * kk + 4 * hh; unsigned e[8];
#pragma unroll
                for (int jj = 0; jj < 8; ++jj) { const unsigned wv = tile[(rb + 8 * (jj >> 2) + (jj & 3)) * 33 + (col >> 1)]; e[jj] = (col & 1) ? (wv >> 16) : (wv & 0xffffu); }
                v4u o; o.x = e[0] | (e[1] << 16); o.y = e[2] | (e[3] << 16); o.z = e[4] | (e[5] << 16); o.w = e[6] | (e[7] << 16);
                *(v4u*)(dst + (it * 64 + w.lane) * 8) = o; }
            LDS_WAIT(); asm volatile("" ::: "memory");
        }
    }
}

struct TileTask { int cid, t, row0, cc, ts0, L, srccol, tR, tX, rmcol; bool conv, rope; float scl; };
DEVI TileTask tiles_decode(int task) {
    TileTask k; k.cid = task / 36; k.t = task % 36; k.row0 = chunk_row0(k.cid); k.cc = k.cid % NCH;
    k.ts0 = k.cc < 2 ? k.cc * 128 : (k.cc - 2) * 128; k.L = k.cc < 2 ? CTXL : SEQ;
    k.tR = -1; k.tX = -1; k.rmcol = -1; k.conv = false; k.rope = false; k.scl = 1.0f; const int t = k.t;
    if (t < 12) { k.conv = true; k.srccol = PC_XBC + t * 64; if (t < 8) { k.rmcol = t * 64; k.tX = 6 + t; } else if (t < 10) { k.tR = 2 + (t - 8); k.tX = 4 + (t - 8); } else k.tR = t - 10; }
    else if (t < 20) { k.rope = true; k.srccol = PC_Q + (t - 12) * 64; k.tR = 14 + (t - 12); }
    else if (t < 28) { k.rope = true; k.srccol = PC_K + (t - 20) * 64; k.tR = 22 + (t - 20); k.tX = 30 + (t - 20); k.scl = 0.125f; }
    else { k.srccol = PC_V + (t - 28) * 64; k.tX = 38 + (t - 28); }
    return k;
}
DEVI void tiles_flush(unsigned char* ws, const TileTask& k, int half, const LAS unsigned* tile, int lane) {
    if (k.rmcol >= 0) {
#pragma unroll 4
        for (int it = 0; it < 8; ++it) { const int row = 64 * half + it * 8 + (lane >> 3), pc = lane & 7; const LAS unsigned* tp = tile + row * 33 + pc * 4;
            v4u ov; ov.x = tp[0]; ov.y = tp[1]; ov.z = tp[2]; ov.w = tp[3]; *(v4u*)((bf16*)(ws + WS_XBC) + (size_t)(k.row0 + row) * 768 + k.rmcol + pc * 8) = ov; }
    }
    if (k.tR >= 0) {
        bf16* frR = (bf16*)(ws + WS_FR) + ((size_t)k.cid * 46 + k.tR) * 8192;
#pragma unroll 4
        for (int q = 0; q < 8; ++q) { const int it = 8 * half + q, rt = it >> 2, ks = it & 3, r = lane & 31, hh = lane >> 5; const LAS unsigned* tp = tile + (32 * rt + r) * 33 + (2 * ks + hh) * 4;
            v4u ov; ov.x = tp[0]; ov.y = tp[1]; ov.z = tp[2]; ov.w = tp[3]; *(v4u*)(frR + (it * 64 + lane) * 8) = ov; }
    }
    if (k.tX >= 0) {
        bf16* frX = (bf16*)(ws + WS_FR) + ((size_t)k.cid * 46 + k.tX) * 8192;
#pragma unroll 2
        for (int q = 0; q < 8; ++q) {
            const int ct = q >> 2, i = 2 * half + ((q >> 1) & 1), kk = q & 1, it = (ct * 4 + i) * 2 + kk, r = lane & 31, hh = lane >> 5, col = 32 * ct + r, rb = 32 * i + 16 * kk + 4 * hh; unsigned e[8];
#pragma unroll
            for (int jj = 0; jj < 8; ++jj) { const unsigned wv = tile[(rb + 8 * (jj >> 2) + (jj & 3)) * 33 + (col >> 1)]; e[jj] = (col & 1) ? (wv >> 16) : (wv & 0xffffu); }
            v4u ov; ov.x = e[0] | (e[1] << 16); ov.y = e[2] | (e[3] << 16); ov.z = e[4] | (e[5] << 16); ov.w = e[6] | (e[7] << 16);
            *(v4u*)(frX + (it * 64 + lane) * 8) = ov; }
    }
}
DEVI void ph_tiles(const Args& A, LAS unsigned char* lds, const Wv& w0, int layer) {
    WV_LOCAL(w0);
    unsigned char* ws = A.ws; const bf16* P = (const bf16*)(ws + WS_P);
    LAS unsigned* tile = (LAS unsigned*)(lds + w.wave * 16896);
    LAS bf16* CW = (LAS bf16*)(lds + 8 * 16896);
    for (int i = w.tid; i < 6 * 768; i += NWAVES * 64) { const float v = i < 5 * 768 ? A.in[9][(size_t)layer * 5 * 768 + i] : A.in[10][layer * 768 + (i - 5 * 768)]; CW[i] = (bf16)f2bf(v); }
    __syncthreads();
    int c8 = w.lane & 7, rg = w.lane >> 3; const int NTASK = NCID * 36;
    TileTask pk = tiles_decode(0); bool pvalid = false;
    for (int task = w.gw; task < NTASK; task += w.NGW) {
        asm volatile("" : "+v"(c8), "+v"(rg));
        const TileTask k = tiles_decode(task);
        const bf16* src = P + (size_t)k.row0 * PS + k.srccol + c8 * 8;
#pragma unroll 1
        for (int half = 0; half < 2; ++half) {
            const int l0 = half * 64 + rg * 8;
            v4u o[8];
            if (k.conv) {
                v4u u[12];
#pragma unroll
                for (int i = 0; i < 12; ++i) { const int l = l0 - 2 + i, tt = k.ts0 + l; const bool ok = tt >= 0 && tt < k.L; const int lc = ok ? l : l0;
                    u[i] = *(const v4u*)(src + (ptrdiff_t)lc * PS); }
                asm volatile("" ::: "memory");
                if (pvalid) tiles_flush(ws, pk, half, tile, w.lane);
                LDS_WAIT(); asm volatile("" ::: "memory");
                float f[12][8], cwv[6][8];
#pragma unroll
                for (int q = 0; q < 6; ++q) { const v4u wq = *(const LAS v4u*)(CW + q * 768 + k.t * 64 + c8 * 8); unpack8(wq, cwv[q]); }
#pragma unroll
                for (int i = 0; i < 12; ++i) { const int tt = k.ts0 + l0 - 2 + i; v4u uu = u[i]; if (!(tt >= 0 && tt < k.L)) uu = (v4u){0u, 0u, 0u, 0u}; unpack8(uu, f[i]); }
#pragma unroll
                for (int i = 0; i < 8; ++i) { float acc[8];
#pragma unroll
                    for (int e = 0; e < 8; ++e) { float a = cwv[5][e];
#pragma unroll
                        for (int q = 0; q < 5; ++q) a += cwv[q][e] * f[i + q][e];
                        acc[e] = silu_f(a); }
                    o[i] = pack8(acc); }
            } else if (k.rope) {
                const bf16* srcp = P + (size_t)k.row0 * PS + k.srccol + (c8 ^ 4) * 8; const float sgn = c8 < 4 ? -1.0f : 1.0f; const int pv = c8 & 3;
                v4u u[8], up[8]; f32x4 ta[4], tdv[4];
#pragma unroll
                for (int i = 0; i < 8; ++i) { u[i] = *(const v4u*)(src + (size_t)(l0 + i) * PS); up[i] = *(const v4u*)(srcp + (size_t)(l0 + i) * PS); }
                { const int tq0 = k.ts0 + l0; const int pos0 = (k.cc < 2) ? 0 : ((pv < 2) ? (tq0 >> 6) : 128 + (tq0 & 63)), posd = (k.cc < 2 || pv < 2) ? 0 : 129;
                  const float* tb = (const float*)(ws + WS_ROPE) + ((size_t)pos0 * 16 + (pv & 1) * 8) * 2; const float* td = (const float*)(ws + WS_ROPE) + ((size_t)posd * 16 + (pv & 1) * 8) * 2;
#pragma unroll
                  for (int q = 0; q < 4; ++q) { ta[q] = *(const f32x4*)(tb + 4 * q); tdv[q] = *(const f32x4*)(td + 4 * q); } }
                asm volatile("" ::: "memory");
                if (pvalid) tiles_flush(ws, pk, half, tile, w.lane);
                LDS_WAIT(); asm volatile("" ::: "memory");
                float cb[8], sb[8], cd[8], sd[8];
#pragma unroll
                for (int e = 0; e < 8; e += 2) { const f32x4 a = ta[e >> 1], d = tdv[e >> 1]; cb[e] = a.x; sb[e] = a.y; cb[e + 1] = a.z; sb[e + 1] = a.w; cd[e] = d.x; sd[e] = d.y; cd[e + 1] = d.z; sd[e + 1] = d.w; }
#pragma unroll
                for (int i = 0; i < 8; ++i) { float own[8], pr[8], ov[8]; unpack8(u[i], own); unpack8(up[i], pr);
#pragma unroll
                    for (int e = 0; e < 8; ++e) { ov[e] = (own[e] * cb[e] + sgn * pr[e] * sb[e]) * k.scl; const float cn = cb[e] * cd[e] - sb[e] * sd[e], sn = sb[e] * cd[e] + cb[e] * sd[e]; cb[e] = cn; sb[e] = sn; }
                    o[i] = pack8(ov); }
            } else {
#pragma unroll
                for (int i = 0; i < 8; ++i) o[i] = *(const v4u*)(src + (size_t)(l0 + i) * PS);
                asm volatile("" ::: "memory");
                if (pvalid) tiles_flush(ws, pk, half, tile, w.lane);
                LDS_WAIT(); asm volatile("" ::: "memory");
            }
#pragma unroll
            for (int i = 0; i < 8; ++i) { LAS unsigned* tp = tile + (l0 + i) * 33 + c8 * 4; tp[0] = o[i].x; tp[1] = o[i].y; tp[2] = o[i].z; tp[3] = o[i].w; }
        }
        LDS_WAIT(); asm volatile("" ::: "memory");
        pk = k; pvalid = true;
    }
    if (pvalid) { tiles_flush(ws, pk, 0, tile, w.lane); tiles_flush(ws, pk, 1, tile, w.lane); }
    LDS_WAIT(); asm volatile("" ::: "memory");
}

DEVI void cum_setup(const Args& A, unsigned char* ws, int layer, int br, int h, int cid, int lane, LAS float* cs, float& decF, float& decB) {
    float af0, af1, ab0, ab1, tf0 = 1.f, tf1 = 1.f, tb0 = 1.f, tb1 = 1.f;
    if (br == 0) { const float* DTT = (const float*)(ws + WS_DTT) + ((size_t)cid * 16 + h) * 128 + 2 * lane; const float2 f = *(const float2*)DTT, bq = *(const float2*)(DTT + 8 * 128); tf0 = f.x; tf1 = f.y; tb0 = bq.x; tb1 = bq.y;
        const float Af = expf(A.in[12][layer * 16 + h]), Ab = expf(A.in[12][layer * 16 + 8 + h]); af0 = -tf0 * Af; af1 = -tf1 * Af; ab0 = -tb0 * Ab; ab1 = -tb1 * Ab; }
    else { const float lf = A.in[17][layer * 16 + h], lb = A.in[17][layer * 16 + 8 + h]; const float lgf = -log1pf(expf(-lf)), lgb = -log1pf(expf(-lb)); af0 = af1 = lgf; ab0 = ab1 = lgb; }
    float pf = af0 + af1, pb = ab0 + ab1;
#pragma unroll
    for (int o = 1; o < 64; o <<= 1) { const float t = __shfl_up(pf, o), u = __shfl_up(pb, o); if (lane >= o) { pf += t; pb += u; } }
    const float totf = __shfl(pf, 63), totb = __shfl(pb, 63);
    const float a0 = pf - af1, a1 = pf;
    const float r0 = totb - (pb - ab0 - ab1), r1 = totb - (pb - ab1);
    cs[2 * lane] = a0; cs[2 * lane + 1] = a1; cs[128 + 2 * lane] = r0; cs[128 + 2 * lane + 1] = r1;
    cs[256 + 2 * lane] = tf0; cs[256 + 2 * lane + 1] = tf1; cs[384 + 2 * lane] = tb0; cs[384 + 2 * lane + 1] = tb1;
    cs[512 + 2 * lane] = tf0 * __expf(totf - a0); cs[512 + 2 * lane + 1] = tf1 * __expf(totf - a1);
    cs[640 + 2 * lane] = tb0 * __expf(totb - r0); cs[640 + 2 * lane + 1] = tb1 * __expf(totb - r1);
    decF = __expf(totf); decB = __expf(totb);
    LDS_WAIT(); asm volatile("" ::: "memory");
}

DEVI void ph_states(const Args& A, LAS unsigned char* lds, const Wv& w0, int layer) {
    WV_LOCAL(w0);
    unsigned char* ws = A.ws; LAS float* cs = (LAS float*)(lds + w.wave * 16384);
    const int hh = w.lane >> 5;
    for (int task2 = w.gw; task2 < 4 * NCID * 8; task2 += w.NGW) {
        const int task = task2 >> 1, dir = task2 & 1;
        const int br = task / (NCID * 8), rem = task % (NCID * 8), cid = rem >> 3, h = rem & 7;
        const bf16* fr = (const bf16*)(ws + WS_FR) + (size_t)cid * 46 * 8192 + w.lane * 8;
        const bf16* xx = fr + (size_t)(br == 0 ? 6 + h : 38 + h) * 8192;
        const bf16* bx = fr + (size_t)(br == 0 ? 4 + (h >> 2) : 30 + h) * 8192;
        bf16x8 af[2][8], bfr[2][8];
#pragma unroll
        for (int t = 0; t < 2; ++t)
#pragma unroll
            for (int k = 0; k < 8; ++k) { af[t][k] = ld8(xx + (t * 8 + k) * 512); bfr[t][k] = ld8(bx + (t * 8 + k) * 512); }
        float decF, decB; cum_setup(A, ws, layer, br, h, cid, w.lane, cs, decF, decB);
        f32x16 acc[2][2];
#pragma unroll
        for (int a = 0; a < 2; ++a)
#pragma unroll
            for (int b = 0; b < 2; ++b)
#pragma unroll
                for (int i = 0; i < 16; ++i) acc[a][b][i] = 0.f;
        const LAS float* wv = cs + 512 + dir * 128 + 4 * hh;
#pragma unroll
        for (int k = 0; k < 8; ++k) {
            const f32x4 w0v = *(const LAS f32x4*)(wv + 16 * k), w1v = *(const LAS f32x4*)(wv + 16 * k + 8);
            bf16x8 aw[2];
#pragma unroll
            for (int pt = 0; pt < 2; ++pt) { float f[8]; unpack8(__builtin_bit_cast(v4u, af[pt][k]), f);
                f[0] *= w0v.x; f[1] *= w0v.y; f[2] *= w0v.z; f[3] *= w0v.w; f[4] *= w1v.x; f[5] *= w1v.y; f[6] *= w1v.z; f[7] *= w1v.w;
                aw[pt] = __builtin_bit_cast(bf16x8, pack8(f)); }
#pragma unroll
            for (int pt = 0; pt < 2; ++pt)
#pragma unroll
                for (int nt = 0; nt < 2; ++nt) acc[pt][nt] = MFMA32(aw[pt], bfr[nt][k], acc[pt][nt]);
        }
        const size_t idx = ((size_t)(br * 2 + dir) * NCID + cid) * 8 + h;
        unsigned* st = (unsigned*)(ws + WS_ST) + idx * 2048 + w.lane;
#pragma unroll
        for (int pt = 0; pt < 2; ++pt)
#pragma unroll
            for (int nt = 0; nt < 2; ++nt)
#pragma unroll
                for (int i2 = 0; i2 < 8; ++i2) st[((pt * 2 + nt) * 8 + i2) * 64] = pk2(acc[pt][nt][2 * i2], acc[pt][nt][2 * i2 + 1]);
        if (w.lane == 0) ((float*)(ws + WS_DEC))[idx] = dir ? decB : decF;
        LDS_WAIT(); asm volatile("" ::: "memory");
    }
}

DEVI void ph_scan(const Args& A, const Wv& w0) {
    WV_LOCAL(w0);
    unsigned char* ws = A.ws; const float* ST = (const float*)(ws + WS_ST); const float* DEC = (const float*)(ws + WS_DEC); bf16* PREV = (bf16*)(ws + WS_PREV);
    for (int gt = w.gw * 64 + w.lane; gt < 2 * 2 * NB * 8 * 1024; gt += w.NGW * 64) {
        const int half = gt & 1, lp = (gt >> 1) & 63, ks = (gt >> 7) & 3, pt = (gt >> 9) & 1, h = (gt >> 10) & 7, b = (gt >> 13) & 3, dir = (gt >> 15) & 1, br = gt >> 16;
        const int rp = lp & 31, hn = lp >> 5, hp = (rp >> 2) & 1, ri = (rp & 3) + 4 * (rp >> 3), n0 = 16 * ks + 8 * hn + 4 * half, nt = n0 >> 5, rn = n0 & 31;
        const int so = ((pt * 2 + nt) * 8 + (ri >> 1)) * 64 + hp * 32 + rn, po = ((pt * 4 + ks) * 64 + lp) * 8 + 4 * half; const bool odd = ri & 1;
        f32x4 s = {0.f, 0.f, 0.f, 0.f};
        v4u sw[6]; float dec[6]; size_t ix[6];
#pragma unroll
        for (int q = 0; q < 6; ++q) { const int k = q; const int c = dir == 0 ? k : (k == 0 ? 1 : (k == 1 ? 0 : NCH + 1 - k));
            ix[q] = ((size_t)(br * 2 + dir) * NCID + b * NCH + c) * 8 + h; sw[q] = *(const v4u*)((const unsigned*)ST + ix[q] * 2048 + so); dec[q] = DEC[ix[q]]; }
#pragma unroll 1
        for (int k0 = 0; k0 < NCH; k0 += 6) {
            f32x4 st[6]; float dc[6]; size_t ic[6];
#pragma unroll
            for (int q = 0; q < 6; ++q) { const v4u v = sw[q]; st[q] = odd ? (f32x4){bfh(v.x), bfh(v.y), bfh(v.z), bfh(v.w)} : (f32x4){bfl(v.x), bfl(v.y), bfl(v.z), bfl(v.w)}; dc[q] = dec[q]; ic[q] = ix[q]; }
            asm volatile("" ::: "memory");
            if (k0 + 6 < NCH) {
#pragma unroll
                for (int q = 0; q < 6; ++q) { const int k = k0 + 6 + q; const int c = dir == 0 ? k : (k == 0 ? 1 : (k == 1 ? 0 : NCH + 1 - k));
                    ix[q] = ((size_t)(br * 2 + dir) * NCID + b * NCH + c) * 8 + h; sw[q] = *(const v4u*)((const unsigned*)ST + ix[q] * 2048 + so); dec[q] = DEC[ix[q]]; } }
            asm volatile("" ::: "memory");
#pragma unroll
            for (int q = 0; q < 6; ++q) { v2u o; o.x = pk2(s.x, s.y); o.y = pk2(s.z, s.w); *(v2u*)(PREV + ic[q] * 4096 + po) = o; s = s * dc[q] + st[q]; }
        }
    }
}

DEVI void ph_outputs(const Args& A, LAS unsigned char* lds, const Wv& w0, int layer, bool skipctx) {
    WV_LOCAL(w0);
    unsigned char* ws = A.ws; LAS float* cs = (LAS float*)(lds + w.wave * 16384); LAS float* yt = cs + 1024;
    const int r = w.lane & 31, hh = w.lane >> 5;
    const bf16* P = (const bf16*)(ws + WS_P);
    for (int task4 = w.gw; task4 < 8 * NCID * 8; task4 += w.NGW) {
        const int task = task4 >> 2, j = task4 & 3;
        const int br = task / (NCID * 8), rem = task % (NCID * 8), cid = rem >> 3, h = rem & 7, row0 = chunk_row0(cid);
        if (skipctx && (cid % NCH) < 2) continue;
        const bf16* fr = (const bf16*)(ws + WS_FR) + (size_t)cid * 46 * 8192 + w.lane * 8;
        const bf16* cf = fr + (size_t)(br == 0 ? (h >> 2) : 14 + h) * 8192;
        const bf16* bf = fr + (size_t)(br == 0 ? 2 + (h >> 2) : 22 + h) * 8192;
        const bf16* xx = fr + (size_t)(br == 0 ? 6 + h : 38 + h) * 8192;
        const bf16* pvf = (const bf16*)(ws + WS_PREV) + (((size_t)(br * 2 + 0) * NCID + cid) * 8 + h) * 4096 + w.lane * 8;
        const bf16* pvb = pvf + (size_t)NCID * 8 * 4096;
        const int l = 32 * j + r;
        bf16x8 Cf[4], pF[2][4], pB[2][4], bA[4], xA[2][2];
#pragma unroll
        for (int ks = 0; ks < 4; ++ks) Cf[ks] = ld8(cf + (j * 4 + ks) * 512);
#pragma unroll
        for (int pt = 0; pt < 2; ++pt)
#pragma unroll
            for (int ks = 0; ks < 4; ++ks) { pF[pt][ks] = ld8(pvf + (pt * 4 + ks) * 512); pB[pt][ks] = ld8(pvb + (pt * 4 + ks) * 512); }
#pragma unroll
        for (int ks = 0; ks < 4; ++ks) bA[ks] = ld8(bf + ks * 512);
#pragma unroll
        for (int kk = 0; kk < 2; ++kk)
#pragma unroll
            for (int pt = 0; pt < 2; ++pt) xA[kk][pt] = ld8(xx + ((pt * 4) * 2 + kk) * 512);
        v4u ep0[4], ep1[4];
        { const int sgp = w.lane & 7;
#pragma unroll
          for (int k = 0; k < 4; ++k) { const size_t rowp = (size_t)(row0 + 32 * j + 8 * k + (w.lane >> 3));
            if (br == 0) { ep0[k] = *(const v4u*)((const bf16*)(ws + WS_XBC) + rowp * 768 + h * 64 + 8 * sgp); ep1[k] = *(const v4u*)(P + rowp * PS + PC_Z + h * 64 + 8 * sgp); }
            else { ep0[k] = *(const v4u*)(P + rowp * PS + PC_G + h * 64 + 8 * sgp); ep1[k] = ep0[k]; } } }
        float decF, decB; cum_setup(A, ws, layer, br, h, cid, w.lane, cs, decF, decB);
        const float acl = cs[l], racl = cs[128 + l]; const float ef = __expf(acl), eb = __expf(racl);
        f32x16 y[2];
#pragma unroll
        for (int pt = 0; pt < 2; ++pt) {
            f32x16 tf, tb;
#pragma unroll
            for (int i = 0; i < 16; ++i) { tf[i] = 0.f; tb[i] = 0.f; }
#pragma unroll
            for (int ks = 0; ks < 4; ++ks) { tf = MFMA32(pF[pt][ks], Cf[ks], tf); tb = MFMA32(pB[pt][ks], Cf[ks], tb); }
#pragma unroll
            for (int i = 0; i < 16; ++i) y[pt][i] = ef * tf[i] + eb * tb[i];
        }
#pragma unroll 1
        for (int i = 0; i < 4; ++i) {
            bf16x8 bN[4], xN[2][2];
            { const int in = i < 3 ? i + 1 : 3;
#pragma unroll
              for (int ks = 0; ks < 4; ++ks) bN[ks] = ld8(bf + (in * 4 + ks) * 512);
#pragma unroll
              for (int kk = 0; kk < 2; ++kk)
#pragma unroll
                for (int pt = 0; pt < 2; ++pt) xN[kk][pt] = ld8(xx + ((pt * 4 + in) * 2 + kk) * 512); }
            f32x16 g;
#pragma unroll
            for (int q = 0; q < 16; ++q) g[q] = 0.f;
#pragma unroll
            for (int ks = 0; ks < 4; ++ks) g = MFMA32(bA[ks], Cf[ks], g);
#pragma unroll
            for (int q4 = 0; q4 < 4; ++q4) {
                const int s0 = 32 * i + 8 * q4 + 4 * hh;
                f32x4 fac = {0.f, 0.f, 0.f, 0.f};
                if (i <= j) { const f32x4 as = *(const LAS f32x4*)(cs + s0), dt = *(const LAS f32x4*)(cs + 256 + s0);
#pragma unroll
                    for (int e = 0; e < 4; ++e) fac[e] += (s0 + e <= l) ? __expf(fminf(acl - as[e], 0.f)) * dt[e] : 0.f; }
                if (i >= j) { const f32x4 rs4 = *(const LAS f32x4*)(cs + 128 + s0), dt = *(const LAS f32x4*)(cs + 384 + s0);
#pragma unroll
                    for (int e = 0; e < 4; ++e) fac[e] += (s0 + e >= l) ? __expf(fminf(racl - rs4[e], 0.f)) * dt[e] : 0.f; }
#pragma unroll
                for (int e = 0; e < 4; ++e) g[q4 * 4 + e] *= fac[e];
            }
#pragma unroll
            for (int kk = 0; kk < 2; ++kk) {
                v4u mw; mw.x = pk2(g[8 * kk + 0], g[8 * kk + 1]); mw.y = pk2(g[8 * kk + 2], g[8 * kk + 3]); mw.z = pk2(g[8 * kk + 4], g[8 * kk + 5]); mw.w = pk2(g[8 * kk + 6], g[8 * kk + 7]);
                const bf16x8 Mf = __builtin_bit_cast(bf16x8, mw);
#pragma unroll
                for (int pt = 0; pt < 2; ++pt) y[pt] = MFMA32(xA[kk][pt], Mf, y[pt]);
            }
#pragma unroll
            for (int ks = 0; ks < 4; ++ks) bA[ks] = bN[ks];
#pragma unroll
            for (int kk = 0; kk < 2; ++kk)
#pragma unroll
                for (int pt = 0; pt < 2; ++pt) xA[kk][pt] = xN[kk][pt];
        }
#pragma unroll
        for (int pt = 0; pt < 2; ++pt)
#pragma unroll
            for (int q = 0; q < 4; ++q) *(LAS f32x4*)(yt + r * 68 + 32 * pt + 8 * q + 4 * hh) = (f32x4){y[pt][4 * q], y[pt][4 * q + 1], y[pt][4 * q + 2], y[pt][4 * q + 3]};
        LDS_WAIT(); asm volatile("" ::: "memory");
        const int sg = w.lane & 7;
        const float dsk = br == 0 ? A.in[13][layer * 8 + h] : 0.f;
#pragma unroll
        for (int k = 0; k < 4; ++k) {
            const int lr = 8 * k + (w.lane >> 3); const size_t row = (size_t)(row0 + 32 * j + lr);
            const f32x4 ya = *(const LAS f32x4*)(yt + lr * 68 + 8 * sg), yb = *(const LAS f32x4*)(yt + lr * 68 + 8 * sg + 4);
            float yv[8] = {ya.x, ya.y, ya.z, ya.w, yb.x, yb.y, yb.z, yb.w};
            if (br == 0) {
                float x[8], z[8]; unpack8(ep0[k], x); unpack8(ep1[k], z);
                const f32x4 n0 = *(const f32x4*)(A.in[14] + layer * 512 + h * 64 + 8 * sg), n1 = *(const f32x4*)(A.in[14] + layer * 512 + h * 64 + 8 * sg + 4);
                const float ng[8] = {n0.x, n0.y, n0.z, n0.w, n1.x, n1.y, n1.z, n1.w};
                float ssq = 0.f;
#pragma unroll
                for (int e = 0; e < 8; ++e) { const float v = (yv[e] + dsk * x[e]) * silu_f(z[e]); ssq += v * v; yv[e] = v * ng[e]; }
                ssq += __shfl_xor(ssq, 1); ssq += __shfl_xor(ssq, 2); ssq += __shfl_xor(ssq, 4);
                if (sg == 0) ((float*)(ws + WS_SSQ))[row * 8 + h] = ssq;
                *(v4u*)((bf16*)(ws + WS_ABR) + row * 512 + h * 64 + 8 * sg) = pack8(yv);
            } else {
                float gz[8]; unpack8(ep0[k], gz);
                float sm = 0.f;
#pragma unroll
                for (int e = 0; e < 8; ++e) sm += yv[e];
                sm += __shfl_xor(sm, 1); sm += __shfl_xor(sm, 2); sm += __shfl_xor(sm, 4); const float mu = sm * (1.0f / 64.0f); float qq = 0.f;
#pragma unroll
                for (int e = 0; e < 8; ++e) { yv[e] -= mu; qq += yv[e] * yv[e]; }
                qq += __shfl_xor(qq, 1); qq += __shfl_xor(qq, 2); qq += __shfl_xor(qq, 4); const float rstd = 1.0f / sqrtf(qq * (1.0f / 64.0f) + EPS);
#pragma unroll
                for (int e = 0; e < 8; ++e) yv[e] = yv[e] * rstd * silu_f(gz[e]);
                *(v4u*)((bf16*)(ws + WS_ABR) + (size_t)2 * T * 512 + row * 512 + h * 64 + 8 * sg) = pack8(yv);
            }
        }
        LDS_WAIT(); asm volatile("" ::: "memory");
    }
}

DEVI void ph_sum3(const Args& A, const Wv& w0, int row_start) {
    WV_LOCAL(w0);
    unsigned char* ws = A.ws; const bf16* YG = (const bf16*)(ws + WS_YG); unsigned char* M8 = ws + WS_ABF; float* SA2 = (float*)(ws + WS_SA2);
#pragma unroll 2
    for (int row = row_start + w.gw; row < T; row += w.NGW) {
        const bf16* yp = YG + (size_t)row * 3072 + w.lane * 16; float f[16];
        { float a[8], b[8], d[8]; unpack8(*(const v4u*)yp, a); unpack8(*(const v4u*)(yp + 1024), b); unpack8(*(const v4u*)(yp + 2048), d);
#pragma unroll
          for (int i = 0; i < 8; ++i) f[i] = (a[i] + b[i]) + d[i];
          unpack8(*(const v4u*)(yp + 8), a); unpack8(*(const v4u*)(yp + 1032), b); unpack8(*(const v4u*)(yp + 2056), d);
#pragma unroll
          for (int i = 0; i < 8; ++i) f[8 + i] = (a[i] + b[i]) + d[i]; }
        float am = 0.f;
#pragma unroll
        for (int i = 0; i < 16; ++i) am = fmaxf(am, fabsf(f[i]));
#pragma unroll
        for (int o = 1; o < 64; o <<= 1) am = fmaxf(am, __shfl_xor(am, o));
        const float inv = am > 0.f ? 127.0f / am : 0.f; unsigned o4[4];
#pragma unroll
        for (int d = 0; d < 4; ++d) { unsigned v = 0;
#pragma unroll
            for (int b = 0; b < 4; ++b) v |= ((unsigned)((int)rintf(f[d * 4 + b] * inv) & 255)) << (8 * b);
            o4[d] = v; }
        v4u ov; ov.x = o4[0]; ov.y = o4[1]; ov.z = o4[2]; ov.w = o4[3];
        *(v4u*)(M8 + (size_t)row * D + w.lane * 16) = ov;
        if (w.lane == 0) SA2[row] = am * (1.0f / 127.0f);
    }
}

DEVI void ph_count(const Args& A, LAS unsigned char* lds, const Wv& w0, int tile0) {
    WV_LOCAL(w0);
    unsigned char* ws = A.ws; const v4i* ROUTE = (const v4i*)(ws + WS_ROUTE); int* CNTT = (int*)(ws + WS_CNTT);
    LAS int* wt = (LAS int*)lds;
    for (int tile = tile0 + w.vcu; tile < 132; tile += w.G) {
        const int s = w.tid, row = tile * 256 + (s >> 1); const v4i rt = ROUTE[row]; const int e = (s & 1) ? rt.y : rt.x;
#pragma unroll
        for (int x = 0; x < 8; ++x) { const unsigned long long m = __ballot(e == x); if (w.lane == 0) wt[w.wave * 8 + x] = __popcll(m); }
        __syncthreads();
        if (w.tid < 8) { int c = 0;
#pragma unroll
            for (int q = 0; q < 8; ++q) c += wt[q * 8 + w.tid]; CNTT[tile * 8 + w.tid] = c; }
        __syncthreads();
    }
}
DEVI void ph_gather(const Args& A, LAS unsigned char* lds, const Wv& w0, int tile0) {
    WV_LOCAL(w0);
    unsigned char* ws = A.ws; const v4i* ROUTE = (const v4i*)(ws + WS_ROUTE); const int* CNTT = (const int*)(ws + WS_CNTT);
    int* SLOTI = (int*)(ws + WS_SLOT); int* INFO = (int*)(ws + WS_MOEINFO); const bf16* TOK = (const bf16*)(ws + WS_ABF); bf16* SORT = (bf16*)(ws + WS_SORT);
    LAS int* cn = (LAS int*)lds;
    LAS int* wt = cn + 1056;
    LAS int* dbase = wt + 64;
    LAS int* tot = dbase + 8;
    LAS int* dst = tot + 8;
    for (int unit = tile0 * 4 + w.vcu; unit < 528; unit += w.G) {
        const int tile = unit >> 2, quarter = unit & 3;
        for (int i = w.tid; i < 1056; i += 512) cn[i] = CNTT[i];
        __syncthreads();
        if (w.tid < 8) { int base = 0, tt = 0; for (int t = tile0; t < 132; ++t) { const int c = cn[t * 8 + w.tid]; if (t < tile) base += c; tt += c; } dbase[w.tid] = base; tot[w.tid] = tt; }
        __syncthreads();
        if (w.tid == 0) { int ps = 0; for (int e = 0; e < 8; ++e) { const int padded = (tot[e] + 255) & ~255; dbase[e] += ps; if (unit == tile0 * 4) INFO[e] = ps >> 8; ps += padded; } if (unit == tile0 * 4) INFO[8] = ps >> 8; }
        const int s = w.tid, row = tile * 256 + (s >> 1); const v4i rt = ROUTE[row]; const int e = (s & 1) ? rt.y : rt.x;
        int myr = 0;
#pragma unroll
        for (int x = 0; x < 8; ++x) { const unsigned long long m = __ballot(e == x); if (e == x) myr = __popcll(m & ((1ull << w.lane) - 1ull)); if (w.lane == 0) wt[w.wave * 8 + x] = __popcll(m); }
        __syncthreads();
        int rank = myr; for (int q = 0; q < w.wave; ++q) rank += wt[q * 8 + e];
        const int d = dbase[e] + rank; dst[s] = d;
        if ((s >> 7) == quarter) SLOTI[(size_t)row * 2 + (s & 1)] = d;
        __syncthreads();
#pragma unroll 4
        for (int j = 0; j < 16; ++j) { const int sl = quarter * 128 + w.wave * 16 + j, r2 = tile * 256 + (sl >> 1); const int dd = dst[sl];
            const v4u a = *(const v4u*)((const unsigned char*)TOK + (size_t)r2 * D + w.lane * 16);
            *(v4u*)((unsigned char*)SORT + (size_t)dd * D + w.lane * 16) = a;
            if (w.lane == 0) ((float*)(ws + WS_SAS))[dd] = ((const float*)(ws + WS_SA))[r2]; }
        __syncthreads();
    }
}

__global__ void __launch_bounds__(NWAVES * 64, 2) mixer_fwd(Args args) {
    extern __shared__ __attribute__((aligned(16))) unsigned char lds_raw[];
    LAS unsigned char* lds = (LAS unsigned char*)lds_raw;
    volatile LAS unsigned* MISC = (volatile LAS unsigned*)(lds + MISC_OFF);
    Wv w; w.tid = threadIdx.x; w.lane = w.tid & 63; w.wave = __builtin_amdgcn_readfirstlane(w.tid >> 6);
    w.G = gridDim.x; { const int bx = blockIdx.x; w.vcu = (w.G % 8 == 0) ? (bx % 8) * (w.G / 8) + bx / 8 : bx; }
    w.gw = w.vcu * NWAVES + w.wave; w.NGW = w.G * NWAVES;
    unsigned char* ws = args.ws;
    for (int u = w.tid; u < (LDS_BYTES - RING_BYTES) / 4; u += NWAVES * 64) ((LAS unsigned*)(lds + RING_BYTES))[u] = 0u;
    __syncthreads();
    XcdBarrier bar = xcd_barrier_post((unsigned*)(ws + WS_CTL) + CW_BAR, MISC + 8);
#define GRID_BAR() xcd_barrier(bar)
#define OPQ(x) asm volatile("" : "+s"(x))

    for (int rep = 0; rep < REP_PRO; ++rep) { ph_prologue(args, lds, w);
    GRID_BAR(); }

    bf16* ABF = (bf16*)(ws + WS_ABF); bf16* X = (bf16*)(ws + WS_X); const float* MOD = (const float*)(ws + WS_MOD);
    for (int layer = 0; layer < DEPTH; ++layer) {
        if (layer == 0) for (int rep = 0; rep < REP_QW; ++rep) ph_quant_w(args, lds, w);
        if (layer == 2) ph_norm<0, true, false, true>(args, w, layer, 1); else for (int rep = 0; rep < REP_N1; ++rep) ph_norm<0, false, false, true>(args, w, layer, 0, 0, layer == 0);
        GRID_BAR();
        { unsigned char* ws = args.ws; OPQ(ws); int Gl = w.G; OPQ(Gl); pg8::Gemm g{ABF, (const bf16*)(ws + WS_WIN + (size_t)layer * NP * 1024), T, NP, 512}; pg8::StaticOrder S; S.init(T, NP, Gl, (int)blockIdx.x);
          pg8::EpiStoreBf16i8<false> E{(bf16*)(ws + WS_P), PS, (const float*)(ws + WS_SA), (const float*)(ws + WS_SBW) + (size_t)layer * NP, 1 << 20};
          for (int rep = 0; rep < REP_WIN; ++rep) { pg8::gemm_phase<pg8::EpiStoreBf16i8<false>, pg8::StaticOrder, true, true, true>(lds, g, S, E); if (rep + 1 < REP_WIN) GRID_BAR(); } }
        GRID_BAR();
        for (int rep = 0; rep < REP_PREP; ++rep) { for (int r2 = 0; r2 < REP_P2; ++r2) ph_prep2(args, w, layer); for (int r2 = 0; r2 < REP_TL; ++r2) ph_tiles(args, lds, w, layer);
        GRID_BAR(); }
        for (int rep = 0; rep < REP_ST; ++rep) { ph_states(args, lds, w, layer);
        GRID_BAR(); }
        for (int rep = 0; rep < REP_SC; ++rep) { ph_scan(args, w);
        GRID_BAR(); }
        const int pm0 = layer == DEPTH - 1 ? 4 : 0;
        for (int rep = 0; rep < REP_OUT; ++rep) { ph_outputs(args, lds, w, layer, pm0 != 0);
        GRID_BAR(); }
        { unsigned char* ws = args.ws; OPQ(ws); int Gl = w.G; OPQ(Gl); pg8::Gemm g{(const bf16*)(ws + WS_ABR), (const bf16*)(ws + WS_WBR) + (size_t)layer * 3 * D * 512, 3 * T, 3 * D, 512}; pg8::MergeOrder S; S.init(T - pm0 * 256, 3 * D, Gl, (int)blockIdx.x, pm0);
          pg8::EpiGate E{(const bf16*)(ws + WS_P), (bf16*)(ws + WS_YG), (const float*)(ws + WS_SSQ)};
          for (int rep = 0; rep < REP_MRG; ++rep) { pg8::gemm_phase<pg8::EpiGate, pg8::MergeOrder, true, true>(lds, g, S, E); if (rep + 1 < REP_MRG) GRID_BAR(); } }
        GRID_BAR();
        for (int rep = 0; rep < REP_SUM3; ++rep) ph_sum3(args, w, pm0 * 256);
        GRID_BAR();
        { unsigned char* ws = args.ws; OPQ(ws); int Gl = w.G; OPQ(Gl); pg8::Gemm g{ABF, (const bf16*)(ws + WS_WOUT + (size_t)layer * D * D), T, D, 512}; pg8::StaticOrder S; S.init(T - pm0 * 256, D, Gl, (int)blockIdx.x, pm0);
          pg8::EpiResidI8<false> E{X, MOD + (size_t)layer * 5 * 6144 + 2048, (const float*)(ws + WS_SA2), (const float*)(ws + WS_SBO) + (size_t)layer * D, args.in[2], args.in[0] - (size_t)NCTX * D, layer == 0 ? 1 : 0};
          pg8::gemm_phase<pg8::EpiResidI8<false>, pg8::StaticOrder, true, true, true>(lds, g, S, E); }
        GRID_BAR();
        if ((layer & 1) == 0) {
            for (int rep = 0; rep < REP_N2; ++rep) ph_norm<1, false, false, true>(args, w, layer, 0);
            GRID_BAR();
            { unsigned char* ws = args.ws; OPQ(ws); int Gl = w.G; OPQ(Gl); pg8::Gemm g{ABF, (const bf16*)(ws + WS_W13 + (size_t)(layer >> 1) * 2 * FF * 1024), T, 2 * FF, 512}; pg8::StaticOrder S; S.init(T, 2 * FF, Gl, (int)blockIdx.x);
              pg8::EpiSwiGLUf8 E{ws + WS_ACT8, FF, 1 << 20, (const float*)(ws + WS_SA), (const float*)(ws + WS_SB13) + (size_t)(layer >> 1) * 2 * FF};
              for (int rep = 0; rep < REP_FFN1; ++rep) { pg8::gemm_phase<pg8::EpiSwiGLUf8, pg8::StaticOrder, true, true, true>(lds, g, S, E); if (rep + 1 < REP_FFN1) GRID_BAR(); } }
            GRID_BAR();
            { unsigned char* ws = args.ws; OPQ(ws); int Gl = w.G; OPQ(Gl); pg8::Gemm g{(const bf16*)(ws + WS_ACT8), (const bf16*)(ws + WS_W2 + (size_t)(layer >> 1) * D * FF), T, D, FF / 2}; pg8::StaticOrder S; S.init(T, D, Gl, (int)blockIdx.x);
              pg8::EpiResidI8<true> E{X, MOD + (size_t)layer * 5 * 6144 + 5120, (const float*)(ws + WS_SACT), (const float*)(ws + WS_SB2) + (size_t)(layer >> 1) * D, args.in[2], args.in[0], 0};
              pg8::gemm_phase<pg8::EpiResidI8<true>, pg8::StaticOrder, true, true, false, true>(lds, g, S, E); }
            GRID_BAR();
        } else {
            ph_norm<1, false, true, true>(args, w, layer, 0, pm0 * 256);
            GRID_BAR();
            for (int rep = 0; rep < REP_MOE; ++rep) {
            ph_count(args, lds, w, pm0);
            GRID_BAR();
            ph_gather(args, lds, w, pm0);
            GRID_BAR();
            pg8::MoeOrder S; { const int* INFO = (const int*)(ws + WS_MOEINFO);
#pragma unroll
                for (int j = 0; j < 9; ++j) S.ts[j] = __builtin_amdgcn_readfirstlane(INFO[j]);
                S.R = S.ts[8]; S.G = w.G; S.c = (int)blockIdx.x; }
            { unsigned char* ws = args.ws; OPQ(ws); S.NT = 28; pg8::Gemm g{(const bf16*)(ws + WS_SORT), (const bf16*)(ws + WS_M13 + (size_t)(layer >> 1) * NEXP * 2 * EFF * 1024), CAP, NEXP * 2 * EFF, 512};
              pg8::EpiSwiGLUf8 E{ws + WS_ACT8, EFF, 28, (const float*)(ws + WS_SAS), (const float*)(ws + WS_SBM) + (size_t)(layer >> 1) * NEXP * 2 * EFF};
              for (int rep = 0; rep < REP_GM1; ++rep) { pg8::gemm_phase<pg8::EpiSwiGLUf8, pg8::MoeOrder, true, true, true>(lds, g, S, E); if (rep + 1 < REP_GM1) GRID_BAR(); } }
            GRID_BAR();
            { unsigned char* ws = args.ws; OPQ(ws); S.NT = 4; pg8::Gemm g{(const bf16*)(ws + WS_ACT8), (const bf16*)(ws + WS_M2 + (size_t)(layer >> 1) * NEXP * D * EFF), CAP, NEXP * D, EFF / 2};
              pg8::EpiStoreBf16i8<true> E{(bf16*)(ws + WS_YB), D, (const float*)(ws + WS_SACT), (const float*)(ws + WS_SBM2) + (size_t)(layer >> 1) * NEXP * D, 4};
              for (int rep = 0; rep < REP_GM2; ++rep) { pg8::gemm_phase<pg8::EpiStoreBf16i8<true>, pg8::MoeOrder, true, true, false, true>(lds, g, S, E); if (rep + 1 < REP_GM2) GRID_BAR(); } }
            GRID_BAR();
            }
        }
    }
    ph_norm<2, true, false>(args, w, 0, 3);
}

extern "C" void kernel_launch(void* const* d_in, const int* in_sizes, int n_in, void* d_out, int out_size, void* d_ws, size_t ws_size, hipStream_t stream) {
    static int grid = 0;
    if (grid == 0) {
        if (n_in != 26 || out_size != NB * SEQ * D || ws_size < WS_END) { fprintf(stderr, "kernel_launch: unexpected shapes (n_in %d, out %d, ws %zu, need %zu)\n", n_in, out_size, ws_size, (size_t)WS_END); grid = -1; return; }
        int dev = 0, cus = 0, per_cu = 0;
        if (hipGetDevice(&dev) != hipSuccess || hipDeviceGetAttribute(&cus, hipDeviceAttributeMultiprocessorCount, dev) != hipSuccess) { grid = -1; return; }
        if (hipFuncSetAttribute((const void*)mixer_fwd, hipFuncAttributeMaxDynamicSharedMemorySize, LDS_BYTES) != hipSuccess) { fprintf(stderr, "kernel_launch: hipFuncSetAttribute failed\n"); grid = -1; return; }
        if (hipOccupancyMaxActiveBlocksPerMultiprocessor(&per_cu, (const void*)mixer_fwd, NWAVES * 64, LDS_BYTES) != hipSuccess || per_cu < 1)
            fprintf(stderr, "kernel_launch: occupancy query reports %d workgroups per CU\n", per_cu);
        (void)hipGetLastError();
        grid = cus;
    }
    if (grid < 0) return;
    if (hipMemsetAsync((char*)d_ws + WS_CTL, 0, CTL_ZERO_BYTES, stream) != hipSuccess) return;
    Args a{};
    for (int i = 0; i < 26; ++i) a.in[i] = (const float*)d_in[i];
    a.out = (float*)d_out; a.ws = (unsigned char*)d_ws;
    hipLaunchKernelGGL(mixer_fwd, dim3(grid), dim3(NWAVES * 64), LDS_BYTES, stream, a);
}
```

```cpp
#include <hip/hip_runtime.h>
#include <cstdio>
#include <cstdint>
namespace pg8 {
#define PG8_LAS __attribute__((address_space(3)))
#define PG8_G __attribute__((address_space(1)))
typedef unsigned short bf16_t;
typedef short bf16x8 __attribute__((ext_vector_type(8)));
typedef float f32x4 __attribute__((ext_vector_type(4)));
typedef unsigned u32x4 __attribute__((ext_vector_type(4)));
typedef int i32x4 __attribute__((ext_vector_type(4)));
typedef int i32x8 __attribute__((ext_vector_type(8)));
constexpr int G8_STRIDE = 3200;
constexpr int BM = 256, BK = 64, HALF = 128, HTB = HALF * BK * 2  , STAGE_BYTES = 8 * HTB, NXCD = 8, WGM = 4;

__host__ __device__ __forceinline__ int lds_byte(int r, int c) { const int st = (r >> 4) * 2 + (c >> 5), rr = r & 15, cc = c & 31, ob = rr * 64 + cc * 2; return st * 1024 + (ob ^ (((ob >> 9) & 1) << 5)); }
__host__ __device__ __forceinline__ void stage_rc(int b, int& R, int& C) { const int st = b / 1024, sb = b % 1024, swz = sb ^ (((sb >> 9) & 1) << 5); R = (st >> 1) * 16 + swz / 64; C = (st & 1) * 32 + (swz % 64) / 2; }
__host__ __device__ __forceinline__ int perm32(int rho) { const int n = rho >> 4, i = rho & 15; return 8 * (i >> 2) + 4 * n + (i & 3); }

struct Unit { int pm, pn; };
struct Gemm { const bf16_t* A; const bf16_t* Bt; int M, N, K; };

struct StaticOrder {
    int nM, nN, nwg, G, c, pm0;
    __host__ __device__ void init(int M, int N, int G_, int c_, int pm0_ = 0) { nM = M / BM; nN = N / BM; nwg = nM * nN; G = G_; c = c_; pm0 = pm0_; }
    __host__ __device__ bool next(int i, Unit& u) const {
        const long L = (long)i * G + c; if (L >= nwg) return false;
        int wgid = (int)L; { const int q = nwg / NXCD, r = nwg % NXCD, xcd = wgid % NXCD, off = wgid / NXCD; wgid = (xcd < r ? xcd * (q + 1) : r * (q + 1) + (xcd - r) * q) + off; }
        const int nig = WGM * nN, gid = wgid / nig, fm = gid * WGM, gsz = (nM - fm) < WGM ? (nM - fm) : WGM;
        u.pm = pm0 + fm + ((wgid % nig) % gsz); u.pn = (wgid % nig) / gsz; return true;
    }
    __device__ __forceinline__ void a_ready(const Unit&) const {}
    __device__ __forceinline__ void done(const Unit&) const {}
};

__device__ __forceinline__ unsigned cvt_pk_bf16(float lo, float hi) { unsigned r; asm volatile("v_cvt_pk_bf16_f32 %0, %1, %2" : "=v"(r) : "v"(lo), "v"(hi)); return r; }
typedef unsigned u32x2 __attribute__((ext_vector_type(2)));
__device__ __forceinline__ float silu_f(float x) { return x * __builtin_amdgcn_rcpf(1.0f + __expf(-x)); }
__device__ __forceinline__ float sigm_f(float x) { return __builtin_amdgcn_rcpf(1.0f + __expf(-x)); }
__device__ __forceinline__ float bfl(unsigned w) { return __uint_as_float(w << 16); }
__device__ __forceinline__ float bfh(unsigned w) { return __uint_as_float(w & 0xffff0000u); }

struct EpiStoreBf16 {
    static constexpr bool PERM = true, AFTER_DRAIN = false; static constexpr int NST = 0;
    bf16_t* O; int ldc; int NT;
    __device__ __forceinline__ void operator()(const f32x4 (&acc)[2][2][4][2], const Unit& u, int wr, int wc, int fr, int fq) const {
        const int row0 = u.pm * BM + wr * 64 + fr, col0 = (u.pn % NT) * BM + wc * 32 + 8 * fq;
#pragma unroll
        for (int ai = 0; ai < 2; ++ai)
#pragma unroll
            for (int m = 0; m < 4; ++m) { bf16_t* rowp = O + (size_t)(row0 + ai * HALF + m * 16) * ldc + col0;
#pragma unroll
                for (int bj = 0; bj < 2; ++bj) { const f32x4 v0 = acc[ai][bj][m][0], v1 = acc[ai][bj][m][1];
                    u32x4 w; w.x = cvt_pk_bf16(v0[0], v0[1]); w.y = cvt_pk_bf16(v0[2], v0[3]); w.z = cvt_pk_bf16(v1[0], v1[1]); w.w = cvt_pk_bf16(v1[2], v1[3]);
                    *(u32x4*)(rowp + bj * HALF) = w; } }
    }
};
template <bool F8 = false>
struct EpiStoreBf16i8 {
    static constexpr bool PERM = true, AFTER_DRAIN = false; static constexpr int NST = 8;
    bf16_t* O; int ldc; const float* sA; const float* sB; int NT; unsigned char* G8;
    __device__ __forceinline__ void operator()(const f32x4 (&acc)[2][2][4][2], const Unit& u, int wr, int wc, int fr, int fq) const {
        const int row0 = u.pm * BM + wr * 64 + fr, col0 = ((G8 != nullptr && u.pn == 27) ? 15 : (u.pn % NT)) * BM + wc * 32 + 8 * fq, bcol0 = u.pn * BM + wc * 32 + 8 * fq;
        f32x4 sb[2][2];
#pragma unroll
        for (int bj = 0; bj < 2; ++bj) { sb[bj][0] = *(const PG8_G f32x4*)(sB + bcol0 + bj * HALF); sb[bj][1] = *(const PG8_G f32x4*)(sB + bcol0 + bj * HALF + 4); }
        float sav[2][4];
#pragma unroll
        for (int ai = 0; ai < 2; ++ai)
#pragma unroll
            for (int m = 0; m < 4; ++m) sav[ai][m] = F8 ? 1.0f : ((const PG8_G float*)sA)[row0 + ai * HALF + m * 16];
        if (!F8 && G8 != nullptr && u.pn >= 15 && u.pn < 27) {
            const int gcol = (u.pn - 15) * BM + wc * 32 + 16 * (fq >> 1), odd = fq & 1;
#pragma unroll
            for (int ai = 0; ai < 2; ++ai)
#pragma unroll
                for (int mp = 0; mp < 2; ++mp)
#pragma unroll
                    for (int bj = 0; bj < 2; ++bj) { unsigned pk[2][2];
#pragma unroll
                        for (int mm = 0; mm < 2; ++mm) { const int m = mp * 2 + mm; const float sa = sav[ai][m]; const i32x4 i0 = __builtin_bit_cast(i32x4, acc[ai][bj][m][0]), i1 = __builtin_bit_cast(i32x4, acc[ai][bj][m][1]); unsigned lo = 0, hi = 0;
#pragma unroll
                            for (int j = 0; j < 4; ++j) { lo = __builtin_amdgcn_cvt_pk_u8_f32(255.0f * sigm_f(((float)i0[j] * sa) * sb[bj][0][j]), j, lo); hi = __builtin_amdgcn_cvt_pk_u8_f32(255.0f * sigm_f(((float)i1[j] * sa) * sb[bj][1][j]), j, hi);        }
                            pk[mm][0] = lo; pk[mm][1] = hi; }
                        const u32x2 r0 = __builtin_amdgcn_permlane16_swap(pk[0][0], pk[1][0], false, false), r1 = __builtin_amdgcn_permlane16_swap(pk[0][1], pk[1][1], false, false);
                        u32x4 w; w.x = r0[0]; w.y = r1[0]; w.z = r0[1]; w.w = r1[1];
                        *(PG8_G u32x4*)(G8 + (size_t)(row0 + ai * HALF + (mp * 2 + odd) * 16) * G8_STRIDE + gcol + bj * HALF) = w; __builtin_amdgcn_sched_barrier(0); }
            return;
        }
#pragma unroll
        for (int ai = 0; ai < 2; ++ai)
#pragma unroll
            for (int m = 0; m < 4; ++m) { const int row = row0 + ai * HALF + m * 16; bf16_t* rowp = O + (size_t)row * ldc + col0; const float sa = sav[ai][m];
#pragma unroll
                for (int bj = 0; bj < 2; ++bj) { const i32x4 i0 = __builtin_bit_cast(i32x4, acc[ai][bj][m][0]), i1 = __builtin_bit_cast(i32x4, acc[ai][bj][m][1]); f32x4 v0, v1;
#pragma unroll
                    for (int j = 0; j < 4; ++j) { if constexpr (F8) { v0[j] = acc[ai][bj][m][0][j] * sb[bj][0][j]; v1[j] = acc[ai][bj][m][1][j] * sb[bj][1][j]; } else { v0[j] = (float)i0[j] * (sa * sb[bj][0][j]); v1[j] = (float)i1[j] * (sa * sb[bj][1][j]); } }
                    u32x4 w; w.x = cvt_pk_bf16(v0[0], v0[1]); w.y = cvt_pk_bf16(v0[2], v0[3]); w.z = cvt_pk_bf16(v1[0], v1[1]); w.w = cvt_pk_bf16(v1[2], v1[3]);
                    *(PG8_G u32x4*)(rowp + bj * HALF) = w; } }
    }
};
struct EpiSwiGLU {
    static constexpr bool PERM = true, AFTER_DRAIN = false; static constexpr int NST = 0;
    bf16_t* O; int ldc; int NT;
    __device__ __forceinline__ void operator()(const f32x4 (&acc)[2][2][4][2], const Unit& u, int wr, int wc, int fr, int fq) const {
        const int ct = u.pn % NT; const int row0 = u.pm * BM + wr * 64 + fr, col0 = ct * HALF + wc * 32 + 8 * fq;
#pragma unroll
        for (int ai = 0; ai < 2; ++ai)
#pragma unroll
            for (int m = 0; m < 4; ++m) { bf16_t* rowp = O + (size_t)(row0 + ai * HALF + m * 16) * ldc + col0;
                const f32x4 g0 = acc[ai][0][m][0], g1 = acc[ai][0][m][1], u0 = acc[ai][1][m][0], u1 = acc[ai][1][m][1];
                u32x4 w; w.x = cvt_pk_bf16(silu_f(g0[0]) * u0[0], silu_f(g0[1]) * u0[1]); w.y = cvt_pk_bf16(silu_f(g0[2]) * u0[2], silu_f(g0[3]) * u0[3]);
                w.z = cvt_pk_bf16(silu_f(g1[0]) * u1[0], silu_f(g1[1]) * u1[1]); w.w = cvt_pk_bf16(silu_f(g1[2]) * u1[2], silu_f(g1[3]) * u1[3]);
                *(PG8_G u32x4*)rowp = w; }
    }
};
struct EpiSwiGLUi8 {
    static constexpr bool PERM = true, AFTER_DRAIN = false; static constexpr int NST = 0;
    bf16_t* O; int ldc; int NT; const float* sA; const float* sB;
    __device__ __forceinline__ void operator()(const f32x4 (&acc)[2][2][4][2], const Unit& u, int wr, int wc, int fr, int fq) const {
        const int ct = u.pn % NT; const int row0 = u.pm * BM + wr * 64 + fr, col0 = ct * HALF + wc * 32 + 8 * fq; const float* sb = sB + (size_t)u.pn * BM + wc * 32 + 8 * fq;
        const f32x4 sg0 = *(const PG8_G f32x4*)sb, sg1 = *(const PG8_G f32x4*)(sb + 4), su0 = *(const PG8_G f32x4*)(sb + HALF), su1 = *(const PG8_G f32x4*)(sb + HALF + 4);
        float sav[2][4];
#pragma unroll
        for (int ai = 0; ai < 2; ++ai)
#pragma unroll
            for (int m = 0; m < 4; ++m) sav[ai][m] = ((const PG8_G float*)sA)[row0 + ai * HALF + m * 16];
#pragma unroll
        for (int ai = 0; ai < 2; ++ai)
#pragma unroll
            for (int m = 0; m < 4; ++m) { const int row = row0 + ai * HALF + m * 16; bf16_t* rowp = O + (size_t)row * ldc + col0; const float sa = sav[ai][m];
                const i32x4 gi0 = __builtin_bit_cast(i32x4, acc[ai][0][m][0]), gi1 = __builtin_bit_cast(i32x4, acc[ai][0][m][1]), ui0 = __builtin_bit_cast(i32x4, acc[ai][1][m][0]), ui1 = __builtin_bit_cast(i32x4, acc[ai][1][m][1]);
                f32x4 g0, g1, u0, u1;
#pragma unroll
                for (int j = 0; j < 4; ++j) { g0[j] = (float)gi0[j] * (sa * sg0[j]); g1[j] = (float)gi1[j] * (sa * sg1[j]); u0[j] = (float)ui0[j] * (sa * su0[j]); u1[j] = (float)ui1[j] * (sa * su1[j]); }
                u32x4 w; w.x = cvt_pk_bf16(silu_f(g0[0]) * u0[0], silu_f(g0[1]) * u0[1]); w.y = cvt_pk_bf16(silu_f(g0[2]) * u0[2], silu_f(g0[3]) * u0[3]);
                w.z = cvt_pk_bf16(silu_f(g1[0]) * u1[0], silu_f(g1[1]) * u1[1]); w.w = cvt_pk_bf16(silu_f(g1[2]) * u1[2], silu_f(g1[3]) * u1[3]);
                *(PG8_G u32x4*)rowp = w; }
    }
};
struct EpiSwiGLUf8 {
    static constexpr bool PERM = true, AFTER_DRAIN = false; static constexpr int NST = 4;
    unsigned char* O; int ldc; int NT; const float* sA; const float* sB;
    __device__ __forceinline__ void operator()(const f32x4 (&acc)[2][2][4][2], const Unit& u, int wr, int wc, int fr, int fq) const {
        const int ct = u.pn % NT; const int row0 = u.pm * BM + wr * 64 + fr, colw = ct * HALF + wc * 32 + 16 * (fq >> 1), odd = fq & 1; const float* sb = sB + (size_t)u.pn * BM + wc * 32 + 8 * fq;
        const f32x4 sg0 = *(const PG8_G f32x4*)sb, sg1 = *(const PG8_G f32x4*)(sb + 4), su0 = *(const PG8_G f32x4*)(sb + HALF), su1 = *(const PG8_G f32x4*)(sb + HALF + 4);
        float sav[2][4];
#pragma unroll
        for (int ai = 0; ai < 2; ++ai)
#pragma unroll
            for (int m = 0; m < 4; ++m) sav[ai][m] = ((const PG8_G float*)sA)[row0 + ai * HALF + m * 16];
#pragma unroll
        for (int ai = 0; ai < 2; ++ai)
#pragma unroll
            for (int mp = 0; mp < 2; ++mp) { unsigned pk[2][2];
#pragma unroll
                for (int mm = 0; mm < 2; ++mm) { const int m = mp * 2 + mm; const float sa = sav[ai][m];
                    const i32x4 gi0 = __builtin_bit_cast(i32x4, acc[ai][0][m][0]), gi1 = __builtin_bit_cast(i32x4, acc[ai][0][m][1]), ui0 = __builtin_bit_cast(i32x4, acc[ai][1][m][0]), ui1 = __builtin_bit_cast(i32x4, acc[ai][1][m][1]);
                    float o[8];
#pragma unroll
                    for (int j = 0; j < 4; ++j) { const float g0 = (float)gi0[j] * (sa * sg0[j]), g1 = (float)gi1[j] * (sa * sg1[j]), u0 = (float)ui0[j] * (sa * su0[j]), u1 = (float)ui1[j] * (sa * su1[j]);
                        o[j] = __builtin_amdgcn_fmed3f(silu_f(g0) * u0, -448.0f, 448.0f); o[4 + j] = __builtin_amdgcn_fmed3f(silu_f(g1) * u1, -448.0f, 448.0f); }
                    int lo = __builtin_amdgcn_cvt_pk_fp8_f32(o[0], o[1], 0, false); lo = __builtin_amdgcn_cvt_pk_fp8_f32(o[2], o[3], lo, true);
                    int hi = __builtin_amdgcn_cvt_pk_fp8_f32(o[4], o[5], 0, false); hi = __builtin_amdgcn_cvt_pk_fp8_f32(o[6], o[7], hi, true);
                    pk[mm][0] = (unsigned)lo; pk[mm][1] = (unsigned)hi; }
                const u32x2 r0 = __builtin_amdgcn_permlane16_swap(pk[0][0], pk[1][0], false, false), r1 = __builtin_amdgcn_permlane16_swap(pk[0][1], pk[1][1], false, false);
                u32x4 w; w.x = r0[0]; w.y = r1[0]; w.z = r0[1]; w.w = r1[1];
                *(PG8_G u32x4*)(O + (size_t)(row0 + ai * HALF + (mp * 2 + odd) * 16) * ldc + colw) = w; }
    }
};
struct EpiResid {
    static constexpr bool PERM = false, AFTER_DRAIN = false; static constexpr int NST = 0;
    float* X; const float* gate;
    __device__ __forceinline__ void operator()(const f32x4 (&acc)[2][2][4][2], const Unit& u, int wr, int wc, int fr, int fq) const {
        const int v = u.pm < 4 ? 4 : ((u.pm - 4) >> 5);
        const int row0 = u.pm * BM + wr * 64 + fr, col0 = u.pn * BM + wc * 32 + 4 * fq;
        const float* gv = gate + (size_t)v * 6144 + col0;
        f32x4 gg[2][2];
#pragma unroll
        for (int bj = 0; bj < 2; ++bj)
#pragma unroll
            for (int n = 0; n < 2; ++n) gg[bj][n] = *(const PG8_G f32x4*)(gv + bj * HALF + n * 16);
#pragma unroll
        for (int ai = 0; ai < 2; ++ai) {
            f32x4 xv[4][2][2];
#pragma unroll
            for (int m = 0; m < 4; ++m) { const float* rowp = X + (size_t)(row0 + ai * HALF + m * 16) * 1024 + col0;
#pragma unroll
                for (int bj = 0; bj < 2; ++bj)
#pragma unroll
                    for (int n = 0; n < 2; ++n) xv[m][bj][n] = *(const PG8_G f32x4*)(rowp + bj * HALF + n * 16); }
#pragma unroll
            for (int m = 0; m < 4; ++m) { float* rowp = X + (size_t)(row0 + ai * HALF + m * 16) * 1024 + col0;
#pragma unroll
                for (int bj = 0; bj < 2; ++bj)
#pragma unroll
                    for (int n = 0; n < 2; ++n) *(f32x4*)(rowp + bj * HALF + n * 16) = xv[m][bj][n] + gg[bj][n] * acc[ai][bj][m][n]; }
        }
    }
};
template <bool F8 = false>
struct EpiResidI8 {
    static constexpr bool PERM = true, AFTER_DRAIN = false; static constexpr int NST = 16;
    bf16_t* X; const float* gate; const float* sA; const float* sB; const float* rdc; const float* rdl; int rdf;
    __device__ __forceinline__ void operator()(const f32x4 (&acc)[2][2][4][2], const Unit& u, int wr, int wc, int fr, int fq) const {
        const int v = u.pm < 4 ? 4 : ((u.pm - 4) >> 5);
        const int row0 = u.pm * BM + wr * 64 + fr, col0 = u.pn * BM + wc * 32 + 8 * fq;
        const float* gv = gate + (size_t)v * 6144 + col0;
        f32x4 gg[2][2]; float sav[2][4];
#pragma unroll
        for (int bj = 0; bj < 2; ++bj)
#pragma unroll
            for (int n = 0; n < 2; ++n) gg[bj][n] = *(const PG8_G f32x4*)(gv + bj * HALF + n * 4) * *(const PG8_G f32x4*)(sB + col0 + bj * HALF + n * 4);
#pragma unroll
        for (int ai = 0; ai < 2; ++ai)
#pragma unroll
            for (int m = 0; m < 4; ++m) sav[ai][m] = F8 ? 1.0f : ((const PG8_G float*)sA)[row0 + ai * HALF + m * 16];
        if (rdf) {
            const float* rb = u.pm < 4 ? rdc : rdl;
#pragma unroll
            for (int ai = 0; ai < 2; ++ai)
#pragma unroll
                for (int mh = 0; mh < 2; ++mh) {
                    f32x4 xv[2][2][2];
#pragma unroll
                    for (int mm = 0; mm < 2; ++mm) { const float* rowp = rb + (size_t)(row0 + ai * HALF + (mh * 2 + mm) * 16) * 1024 + col0;
#pragma unroll
                        for (int bj = 0; bj < 2; ++bj)
#pragma unroll
                            for (int n = 0; n < 2; ++n) xv[mm][bj][n] = *(const PG8_G f32x4*)(rowp + bj * HALF + n * 4); }
#pragma unroll
                    for (int mm = 0; mm < 2; ++mm) { const int m = mh * 2 + mm; bf16_t* rowp = X + (size_t)(row0 + ai * HALF + m * 16) * 1024 + col0;
#pragma unroll
                        for (int bj = 0; bj < 2; ++bj) { f32x4 o[2];
#pragma unroll
                            for (int n = 0; n < 2; ++n) { const i32x4 iv = __builtin_bit_cast(i32x4, acc[ai][bj][m][n]); f32x4 fv; if constexpr (F8) fv = acc[ai][bj][m][n]; else { fv[0] = (float)iv[0]; fv[1] = (float)iv[1]; fv[2] = (float)iv[2]; fv[3] = (float)iv[3]; }
                                o[n] = xv[mm][bj][n] + gg[bj][n] * (fv * sav[ai][m]); }
                            u32x4 wv; wv.x = cvt_pk_bf16(o[0][0], o[0][1]); wv.y = cvt_pk_bf16(o[0][2], o[0][3]); wv.z = cvt_pk_bf16(o[1][0], o[1][1]); wv.w = cvt_pk_bf16(o[1][2], o[1][3]);
                            *(PG8_G u32x4*)(rowp + bj * HALF) = wv; } }
                    asm volatile("" ::: "memory");
                }
        } else {
#pragma unroll
            for (int ai = 0; ai < 2; ++ai)
#pragma unroll
                for (int mh = 0; mh < 2; ++mh) {
                    u32x4 xw[2][2];
#pragma unroll
                    for (int mm = 0; mm < 2; ++mm) { const bf16_t* rowp = X + (size_t)(row0 + ai * HALF + (mh * 2 + mm) * 16) * 1024 + col0;
#pragma unroll
                        for (int bj = 0; bj < 2; ++bj) xw[mm][bj] = *(const PG8_G u32x4*)(rowp + bj * HALF); }
#pragma unroll
                    for (int mm = 0; mm < 2; ++mm) { const int m = mh * 2 + mm; bf16_t* rowp = X + (size_t)(row0 + ai * HALF + m * 16) * 1024 + col0;
#pragma unroll
                        for (int bj = 0; bj < 2; ++bj) { const u32x4 q = xw[mm][bj]; f32x4 o[2];
                            o[0][0] = bfl(q.x); o[0][1] = bfh(q.x); o[0][2] = bfl(q.y); o[0][3] = bfh(q.y); o[1][0] = bfl(q.z); o[1][1] = bfh(q.z); o[1][2] = bfl(q.w); o[1][3] = bfh(q.w);
#pragma unroll
                            for (int n = 0; n < 2; ++n) { const i32x4 iv = __builtin_bit_cast(i32x4, acc[ai][bj][m][n]); f32x4 fv; if constexpr (F8) fv = acc[ai][bj][m][n]; else { fv[0] = (float)iv[0]; fv[1] = (float)iv[1]; fv[2] = (float)iv[2]; fv[3] = (float)iv[3]; }
                                o[n] = o[n] + gg[bj][n] * (fv * sav[ai][m]); }
                            u32x4 wv; wv.x = cvt_pk_bf16(o[0][0], o[0][1]); wv.y = cvt_pk_bf16(o[0][2], o[0][3]); wv.z = cvt_pk_bf16(o[1][0], o[1][1]); wv.w = cvt_pk_bf16(o[1][2], o[1][3]);
                            *(PG8_G u32x4*)(rowp + bj * HALF) = wv; } }
                    asm volatile("" ::: "memory");
                }
        }
    }
};
struct EpiGate {
    static constexpr bool PERM = true, AFTER_DRAIN = false; static constexpr int NST = 16;
    const unsigned char* G8; bf16_t* YG; const float* SSQ;
    __device__ __forceinline__ void operator()(const f32x4 (&acc)[2][2][4][2], const Unit& u, int wr, int wc, int fr, int fq) const {
        const int br = u.pn >> 2, rt = u.pm - br * 132;
        const int row0 = rt * BM + wr * 64 + fr, col0 = u.pn * BM + wc * 32 + 8 * fq;
        float rsn[2][4];
#pragma unroll
        for (int ai = 0; ai < 2; ++ai)
#pragma unroll
            for (int m = 0; m < 4; ++m) rsn[ai][m] = 1.0f;
        if (br == 0) {
            f32x4 q[2][4][2];
#pragma unroll
            for (int ai = 0; ai < 2; ++ai)
#pragma unroll
                for (int m = 0; m < 4; ++m) { const float* sp = SSQ + (size_t)(row0 + ai * HALF + m * 16) * 8; q[ai][m][0] = *(const PG8_G f32x4*)sp; q[ai][m][1] = *(const PG8_G f32x4*)(sp + 4); }
#pragma unroll
            for (int ai = 0; ai < 2; ++ai)
#pragma unroll
                for (int m = 0; m < 4; ++m) { const f32x4 q0 = q[ai][m][0], q1 = q[ai][m][1]; rsn[ai][m] = __builtin_amdgcn_rsqf(((q0[0] + q0[1]) + (q0[2] + q0[3]) + (q1[0] + q1[1]) + (q1[2] + q1[3])) * (1.0f / 512.0f) + 1e-6f); }
        }
#pragma unroll
        for (int ai = 0; ai < 2; ++ai) {
            u32x2 gw[4][2];
#pragma unroll
            for (int m = 0; m < 4; ++m)
#pragma unroll
                for (int bj = 0; bj < 2; ++bj) gw[m][bj] = *(const PG8_G u32x2*)(G8 + (size_t)(row0 + ai * HALF + m * 16) * G8_STRIDE + col0 + bj * HALF);
#pragma unroll
            for (int m = 0; m < 4; ++m)
#pragma unroll
                for (int bj = 0; bj < 2; ++bj) { const u32x2 g = gw[m][bj]; const float rs = rsn[ai][m] * (1.0f / 255.0f); const f32x4 v0 = acc[ai][bj][m][0] * rs, v1 = acc[ai][bj][m][1] * rs;
                    u32x4 w; w.x = cvt_pk_bf16(v0[0] * (float)(g.x & 255u), v0[1] * (float)((g.x >> 8) & 255u)); w.y = cvt_pk_bf16(v0[2] * (float)((g.x >> 16) & 255u), v0[3] * (float)(g.x >> 24));
                    w.z = cvt_pk_bf16(v1[0] * (float)(g.y & 255u), v1[1] * (float)((g.y >> 8) & 255u)); w.w = cvt_pk_bf16(v1[2] * (float)((g.y >> 16) & 255u), v1[3] * (float)(g.y >> 24));
                    *(PG8_G u32x4*)(YG + (size_t)(row0 + ai * HALF + m * 16) * 3072 + col0 + bj * HALF) = w; }
        }
    }
};
struct EpiStoreF32 {
    static constexpr bool PERM = false, AFTER_DRAIN = false; static constexpr int NST = 0;
    float* Y; int NT;
    __device__ __forceinline__ void operator()(const f32x4 (&acc)[2][2][4][2], const Unit& u, int wr, int wc, int fr, int fq) const {
        const int ct = u.pn % NT; const int row0 = u.pm * BM + wr * 64 + fr, col0 = ct * BM + wc * 32 + 4 * fq;
#pragma unroll
        for (int ai = 0; ai < 2; ++ai)
#pragma unroll
            for (int m = 0; m < 4; ++m) { float* rowp = Y + (size_t)(row0 + ai * HALF + m * 16) * 1024 + col0;
#pragma unroll
                for (int bj = 0; bj < 2; ++bj)
#pragma unroll
                    for (int n = 0; n < 2; ++n) *(f32x4*)(rowp + bj * HALF + n * 16) = acc[ai][bj][m][n]; }
    }
};
struct MergeOrder : StaticOrder {
    __device__ __forceinline__ bool next(int i, Unit& u) const { if (!StaticOrder::next(i, u)) return false; u.pm += (u.pn >> 2) * 132; return true; }
};
struct MoeOrder {
    int R, NT, G, c; int ts[9];
    __device__ __forceinline__ bool next(int i, Unit& u) const {
        const int nwg = R * NT; const long L = (long)i * G + c; if (L >= nwg) return false;
        int wgid = (int)L; { const int q = nwg / NXCD, r = nwg % NXCD, xcd = wgid % NXCD, off = wgid / NXCD; wgid = (xcd < r ? xcd * (q + 1) : r * (q + 1) + (xcd - r) * q) + off; }
        const int nig = WGM * NT, gid = wgid / nig, fm = gid * WGM, gsz = (R - fm) < WGM ? (R - fm) : WGM;
        const int pm = fm + ((wgid % nig) % gsz), ct = (wgid % nig) / gsz;
        int e = 0;
#pragma unroll
        for (int j = 1; j < 8; ++j) e += (pm >= ts[j]) ? 1 : 0;
        u.pm = pm; u.pn = e * NT + ct; return true;
    }
    __device__ __forceinline__ void a_ready(const Unit&) const {}
    __device__ __forceinline__ void done(const Unit&) const {}
};
template <bool I8> __device__ __forceinline__ f32x4 mma16(bf16x8 b, bf16x8 a, f32x4 c) {
    if constexpr (I8) return __builtin_bit_cast(f32x4, __builtin_amdgcn_mfma_i32_16x16x64_i8(__builtin_bit_cast(i32x4, b), __builtin_bit_cast(i32x4, a), __builtin_bit_cast(i32x4, c), 0, 0, 0));
    else return __builtin_amdgcn_mfma_f32_16x16x32_bf16(b, a, c, 0, 0, 0);
}
__device__ __forceinline__ f32x4 mma_f8(bf16x8 b0, bf16x8 b1, bf16x8 a0, bf16x8 a1, f32x4 c) {
    const i32x8 bb = __builtin_shufflevector(__builtin_bit_cast(i32x4, b0), __builtin_bit_cast(i32x4, b1), 0, 1, 2, 3, 4, 5, 6, 7), aa = __builtin_shufflevector(__builtin_bit_cast(i32x4, a0), __builtin_bit_cast(i32x4, a1), 0, 1, 2, 3, 4, 5, 6, 7);
    asm volatile("s_nop 1\n\tv_mfma_f32_16x16x128_f8f6f4 %0, %1, %2, %0" : "+v"(c) : "v"(bb), "v"(aa));
    return c;
}
template <class Epi, class Sched, bool ALIGN_EPI = false, bool SP2 = false, bool I8 = false, bool F8 = false>
__device__ __forceinline__ void gemm_phase(PG8_LAS unsigned char* lds, const Gemm g, const Sched& S, const Epi& E) {
    int tid_ = threadIdx.x; asm volatile("" : "+v"(tid_));
    const int tid = tid_, wid = __builtin_amdgcn_readfirstlane(tid >> 6), lane = tid & 63, wr = wid >> 2, wc = wid & 3, fr = lane & 15, fq = lane >> 4;
    const int K = g.K, nt = K / BK;
    unsigned voffA, voffB;
    { int R, C; stage_rc(tid * 16, R, C); const int Rb = Epi::PERM ? ((R & ~31) + perm32(R & 31)) : R; voffA = (unsigned)(R * K + C) * 2u; voffB = (unsigned)(Rb * K + C) * 2u; }
    const size_t pstep = (size_t)64 * K * 2;
    const size_t kstep = (size_t)(BK * 2);
    const size_t hstep = (size_t)HALF * K * 2;
    const size_t tstep = 2 * hstep;
    const unsigned ldsw = (unsigned)wid * 1024u;
    const int aoff = lds_byte(wr * 64 + fr, fq * 8), boff = lds_byte(wc * 32 + fr, fq * 8);
#define PG8_SA(b, h) (((b) * 2 + (h)) * HTB)
#define PG8_SB(b, h) ((4 + (b) * 2 + (h)) * HTB)
#define PG8_STAGE(bufoff, gbase, voff) do { _Pragma("unroll") for (int _i = 0; _i < 2; ++_i) \
        __builtin_amdgcn_global_load_lds((const unsigned*)((const char*)(gbase) + _i * pstep + (voff)), (PG8_LAS unsigned*)(lds + (bufoff) + ldsw + _i * 8192), 16, 0, 0); } while (0)
#define PG8_LDA(dst, b, h) do { _Pragma("unroll") for (int m = 0; m < 4; ++m) _Pragma("unroll") for (int k = 0; k < 2; ++k) dst[m][k] = *(const PG8_LAS bf16x8*)(lds + PG8_SA(b, h) + aoff + m * 2048 + k * 1024); } while (0)
#define PG8_LDB(dst, b, h) do { _Pragma("unroll") for (int n = 0; n < 2; ++n) _Pragma("unroll") for (int k = 0; k < 2; ++k) dst[n][k] = *(const PG8_LAS bf16x8*)(lds + PG8_SB(b, h) + boff + n * 2048 + k * 1024); } while (0)
#define PG8_MMA(ai, bj, At, Bt) do { __builtin_amdgcn_s_setprio(1); _Pragma("unroll") for (int m = 0; m < 4; ++m) _Pragma("unroll") for (int n = 0; n < 2; ++n) { \
        if constexpr (F8) acc[ai][bj][m][n] = mma_f8(Bt[n][0], Bt[n][1], At[m][0], At[m][1], acc[ai][bj][m][n]); \
        else { _Pragma("unroll") for (int k = 0; k < 2; ++k) acc[ai][bj][m][n] = mma16<I8>(Bt[n][k], At[m][k], acc[ai][bj][m][n]); } } __builtin_amdgcn_s_setprio(0); } while (0)
#define PG8_WAIT_V(n) asm volatile("s_waitcnt vmcnt(" #n ")" ::: "memory")
#define PG8_WAIT_VF asm volatile("s_waitcnt vmcnt(%0)" :: "n"(8 + Epi::NST) : "memory")
#define PG8_WAIT_L(n) asm volatile("s_waitcnt lgkmcnt(" #n ")" ::: "memory")
#define PG8_BAR __builtin_amdgcn_s_barrier()
#define PG8_SCHED __builtin_amdgcn_sched_barrier(0)
    Unit cur, nxt; int ui = 0;
    if (!S.next(0, cur)) return;
    f32x4 acc[2][2][4][2];
#pragma unroll
    for (int a = 0; a < 2; ++a)
#pragma unroll
        for (int b = 0; b < 2; ++b)
#pragma unroll
            for (int m = 0; m < 4; ++m)
#pragma unroll
                for (int n = 0; n < 2; ++n) acc[a][b][m][n] = (f32x4){0.f, 0.f, 0.f, 0.f};
    bf16x8 At[4][2], B0[2][2], B1[2][2];
    const char* cA = (const char*)g.A + (size_t)cur.pm * tstep; const char* cB = (const char*)g.Bt + (size_t)cur.pn * tstep;
    S.a_ready(cur);
    if constexpr (SP2) {
        PG8_STAGE(PG8_SB(0, 0), cB, voffB); PG8_STAGE(PG8_SB(0, 1), cB + hstep, voffB); PG8_STAGE(PG8_SA(0, 0), cA, voffA); PG8_STAGE(PG8_SA(0, 1), cA + hstep, voffA);
        if (wr == 1) PG8_BAR;
        PG8_WAIT_V(2); PG8_BAR;
        PG8_STAGE(PG8_SB(1, 0), cB + kstep, voffB); PG8_STAGE(PG8_SA(1, 0), cA + kstep, voffA); PG8_STAGE(PG8_SB(1, 1), cB + hstep + kstep, voffB);
        if constexpr (Epi::NST > 0) { PG8_WAIT_V(0); } else { PG8_WAIT_V(6); } PG8_BAR;
    } else {
        PG8_STAGE(PG8_SB(0, 0), cB, voffB); PG8_STAGE(PG8_SA(0, 0), cA, voffA); PG8_STAGE(PG8_SB(0, 1), cB + hstep, voffB); PG8_STAGE(PG8_SA(0, 1), cA + hstep, voffA);
        if (wr == 1) PG8_BAR;
        PG8_WAIT_V(4); PG8_BAR;
        PG8_STAGE(PG8_SB(1, 0), cB + kstep, voffB); PG8_STAGE(PG8_SA(1, 0), cA + kstep, voffA); PG8_STAGE(PG8_SB(1, 1), cB + hstep + kstep, voffB);
        PG8_WAIT_V(6); PG8_BAR;
    }
    for (;;) {
        const bool has_next = S.next(ui + 1, nxt);
        const char* nA = has_next ? (const char*)g.A + (size_t)nxt.pm * tstep : cA; const char* nB = has_next ? (const char*)g.Bt + (size_t)nxt.pn * tstep : cB;
#define PG8_KT2(WV) \
              \
              \
            PG8_LDB(B0, 0, 0); PG8_LDB(B1, 0, 1); PG8_SCHED; PG8_LDA(At, 0, 0); PG8_STAGE(PG8_SA(1, 1), a1 + hstep, voffA); \
            WV; PG8_WAIT_L(0); PG8_BAR; PG8_MMA(0, 0, At, B0); PG8_MMA(0, 1, At, B1); PG8_BAR; PG8_SCHED; \
              \
            PG8_LDA(At, 0, 1); PG8_STAGE(PG8_SB(0, 0), b2, voffB); PG8_STAGE(PG8_SB(0, 1), b2 + hstep, voffB); PG8_STAGE(PG8_SA(0, 0), a2, voffA); \
            WV; PG8_WAIT_L(0); PG8_BAR; PG8_MMA(1, 0, At, B0); PG8_MMA(1, 1, At, B1); PG8_BAR; PG8_SCHED; \
              \
            PG8_LDB(B0, 1, 0); PG8_LDB(B1, 1, 1); PG8_SCHED; PG8_LDA(At, 1, 0); PG8_STAGE(PG8_SA(0, 1), a2 + hstep, voffA); \
            PG8_WAIT_V(8); PG8_WAIT_L(0); PG8_BAR; PG8_MMA(0, 0, At, B0); PG8_MMA(0, 1, At, B1); PG8_BAR; PG8_SCHED; \
              \
            PG8_LDA(At, 1, 1); PG8_STAGE(PG8_SB(1, 0), b3, voffB); PG8_STAGE(PG8_SB(1, 1), b3 + hstep, voffB); PG8_STAGE(PG8_SA(1, 0), a3, voffA); \
            PG8_WAIT_V(8); PG8_WAIT_L(0); PG8_BAR; PG8_MMA(1, 0, At, B0); PG8_MMA(1, 1, At, B1); PG8_BAR; PG8_SCHED;
        if constexpr (SP2) {
            if constexpr (Epi::NST > 0) {
                const char* a1 = cA + kstep; const char* a2 = cA + 2 * kstep; const char* b2 = cB + 2 * kstep; const char* a3 = a2 + kstep; const char* b3 = b2 + kstep;
                PG8_KT2(PG8_WAIT_VF)
            }
            for (int t = Epi::NST > 0 ? 2 : 0; t < nt; t += 2) {
                const bool last = (t == nt - 2);
                const char* a1 = cA + (size_t)(t + 1) * kstep;
                const char* a2 = last ? nA : cA + (size_t)(t + 2) * kstep; const char* b2 = last ? nB : cB + (size_t)(t + 2) * kstep;
                const char* a3 = a2 + kstep; const char* b3 = b2 + kstep;
                if (last && has_next) S.a_ready(nxt);
                PG8_KT2(PG8_WAIT_V(8))
            }
        } else {
        static_assert(SP2 || Epi::NST == 0, "the four-phase loop keeps the plain waits");
        for (int t = 0; t < nt; t += 2) {
            const bool last = (t == nt - 2);
            const char* a1 = cA + (size_t)(t + 1) * kstep;
            const char* a2 = last ? nA : cA + (size_t)(t + 2) * kstep; const char* b2 = last ? nB : cB + (size_t)(t + 2) * kstep;
            const char* a3 = a2 + kstep; const char* b3 = b2 + kstep;
            if (last && has_next) S.a_ready(nxt);
            PG8_LDB(B0, 0, 0); PG8_SCHED; PG8_LDA(At, 0, 0); PG8_STAGE(PG8_SA(1, 1), a1 + hstep, voffA);
            PG8_WAIT_L(8); PG8_BAR; PG8_WAIT_L(0); PG8_MMA(0, 0, At, B0); PG8_BAR; PG8_SCHED;
            PG8_LDB(B1, 0, 1); PG8_STAGE(PG8_SB(0, 0), b2, voffB);
            PG8_BAR; PG8_WAIT_L(0); PG8_MMA(0, 1, At, B1); PG8_BAR;
            PG8_LDA(At, 0, 1); PG8_STAGE(PG8_SA(0, 0), a2, voffA);
            PG8_BAR; PG8_WAIT_L(0); PG8_MMA(1, 0, At, B0); PG8_BAR; PG8_SCHED;
            PG8_STAGE(PG8_SB(0, 1), b2 + hstep, voffB);
            PG8_WAIT_V(6); PG8_BAR; PG8_MMA(1, 1, At, B1); PG8_BAR;
            PG8_LDB(B0, 1, 0); PG8_SCHED; PG8_LDA(At, 1, 0); PG8_STAGE(PG8_SA(0, 1), a2 + hstep, voffA);
            PG8_WAIT_L(8); PG8_BAR; PG8_WAIT_L(0); PG8_MMA(0, 0, At, B0); PG8_BAR; PG8_SCHED;
            PG8_LDB(B1, 1, 1); PG8_STAGE(PG8_SB(1, 0), b3, voffB);
            PG8_BAR; PG8_WAIT_L(0); PG8_MMA(0, 1, At, B1); PG8_BAR;
            PG8_LDA(At, 1, 1); PG8_STAGE(PG8_SA(1, 0), a3, voffA);
            PG8_BAR; PG8_WAIT_L(0); PG8_MMA(1, 0, At, B0); PG8_BAR; PG8_SCHED;
            PG8_STAGE(PG8_SB(1, 1), b3 + hstep, voffB);
            PG8_WAIT_V(6); PG8_BAR; PG8_MMA(1, 1, At, B1); PG8_BAR;
        }
        }
#undef PG8_KT2
        if constexpr (F8) asm volatile("s_nop 15\n\ts_nop 15" ::: "memory");
        if constexpr (ALIGN_EPI) { if (wr == 0) PG8_BAR; }
        if constexpr (!Epi::AFTER_DRAIN) { int te = tid; asm volatile("" : "+v"(te));
            E(acc, cur, wr, wc, te & 15, (te & 63) >> 4); S.done(cur); }
        if (!has_next) break;
#pragma unroll
        for (int a = 0; a < 2; ++a)
#pragma unroll
            for (int b = 0; b < 2; ++b)
#pragma unroll
                for (int m = 0; m < 4; ++m)
#pragma unroll
                    for (int n = 0; n < 2; ++n) acc[a][b][m][n] = (f32x4){0.f, 0.f, 0.f, 0.f};
        cur = nxt; cA = nA; cB = nB; ++ui;
        if constexpr (ALIGN_EPI) { if (wr == 1) PG8_BAR; }
    }
    PG8_WAIT_V(0);
    if constexpr (!ALIGN_EPI) { if (wr == 0) PG8_BAR; }
    PG8_BAR;
    if constexpr (Epi::AFTER_DRAIN) { E.fused(acc, cur, wr, wc, fr, fq, lds, wid, lane); S.done(cur); }
#undef PG8_SA
#undef PG8_SB
#undef PG8_STAGE
#undef PG8_LDA
#undef PG8_LDB
#undef PG8_MMA
#undef PG8_WAIT_V
#undef PG8_WAIT_L
#undef PG8_BAR
#undef PG8_SCHED
}
}

constexpr int D = 1024, NB = 4, SEQ = 8192, DEPTH = 4, CTXL = 256;
constexpr int NCTX = NB * CTXL;
constexpr int T = NCTX + NB * SEQ;
constexpr int NP = 7168;
constexpr int PW = 4096;
constexpr int FF = 2816, EFF = 3584, NEXP = 8;
constexpr int CAP = 2 * T + NEXP * 256;
constexpr int PC_Z = 0, PC_XBC = 512, PC_POOL = 1280, PC_Q = 1792, PC_K = 2304, PC_V = 2816, PC_G = 3328, PC_GATE = 3840, PC_DT = 3840;
constexpr float EPS = 1e-6f;

constexpr size_t MiB = 1u << 20;
constexpr size_t WS_CTL = 0, CTL_ZERO_BYTES = 1 * MiB;
constexpr size_t WS_MOD = 1 * MiB;
constexpr size_t WS_ROUTE = 2 * MiB;
constexpr size_t WS_SLOT = WS_ROUTE + (size_t)T * 16;
constexpr size_t WS_CNTT = WS_SLOT + (size_t)T * 8;
constexpr size_t WS_MOEINFO = WS_CNTT + 132 * 8 * 4;
constexpr size_t WS_ROPE = WS_MOEINFO + 64;
constexpr size_t WS_SA = WS_ROPE + 192 * 16 * 8;
constexpr size_t WS_SAS = WS_SA + (size_t)T * 4;
constexpr size_t WS_SB13 = WS_SAS + (size_t)CAP * 4;
constexpr size_t WS_SBM = WS_SB13 + (size_t)2 * 2 * FF * 4;
constexpr size_t WS_SBW = WS_SBM + (size_t)2 * NEXP * 2 * EFF * 4;
constexpr size_t WS_SBO = WS_SBW + (size_t)DEPTH * NP * 4;
constexpr size_t WS_SB2 = WS_SBO + (size_t)DEPTH * D * 4;
constexpr size_t WS_SBM2 = WS_SB2 + (size_t)2 * D * 4;
constexpr size_t WS_SA2 = WS_SBM2 + (size_t)2 * NEXP * D * 4;
constexpr size_t WS_SACT = WS_SA2 + (size_t)T * 4;
constexpr size_t WS_X = 5 * MiB;
constexpr size_t WS_ABF = WS_X + (size_t)T * D * 4;
constexpr size_t WS_WIN = WS_ABF + (size_t)T * D * 2;
constexpr size_t WS_WBR = WS_WIN + (size_t)DEPTH * NP * D * 2;
constexpr size_t WS_WOUT = WS_WBR + (size_t)DEPTH * 3 * D * 512 * 2;
constexpr size_t WS_W13 = WS_WOUT + (size_t)DEPTH * D * D * 2;
constexpr size_t WS_W2 = WS_W13 + (size_t)2 * 2 * FF * D * 2;
constexpr size_t WS_M13 = WS_W2 + (size_t)2 * D * FF * 2;
constexpr size_t WS_M2 = WS_M13 + (size_t)2 * NEXP * 2 * EFF * D * 2;
constexpr size_t WS_R = WS_M2 + (size_t)2 * NEXP * D * EFF * 2;
constexpr size_t WS_P = WS_R;
constexpr size_t WS_XBC = WS_P + (size_t)T * PW * 2;
constexpr size_t WS_DT = WS_XBC + (size_t)T * 768 * 2;
constexpr size_t WS_QR = WS_DT + (size_t)T * 16 * 4;
constexpr size_t WS_KR = WS_QR + (size_t)T * 512 * 2;
constexpr int NCH = 66, NCID = NB * NCH;
constexpr size_t WS_ST = WS_KR + (size_t)T * 512 * 2;
constexpr size_t WS_YG = WS_ST;
constexpr size_t WS_PREV = WS_ST + (size_t)4 * NCID * 8 * 4096 * 4;
constexpr size_t WS_DEC = WS_PREV + (size_t)4 * NCID * 8 * 4096 * 2;
constexpr size_t WS_SSQ = WS_DEC + (size_t)4 * NCID * 8 * 4;
constexpr size_t WS_FR = WS_SSQ + (size_t)T * 8 * 4;
constexpr size_t WS_DTT = WS_FR + (size_t)NCID * 46 * 8192 * 2;
constexpr size_t WS_ABR = WS_DTT + (size_t)NCID * 16 * 128 * 4;
constexpr size_t WS_G8 = WS_ABR + (size_t)3 * T * 512 * 2;
constexpr size_t WS_MIX_END = WS_G8 + (size_t)T * pg8::G8_STRIDE;
constexpr size_t WS_ACT = WS_R;
constexpr size_t WS_SORT = WS_R;
constexpr size_t WS_ACTM = WS_SORT + (size_t)CAP * D * 2;
constexpr size_t WS_YB = WS_ACTM + (size_t)CAP * EFF * 2;
constexpr size_t WS_ACT8 = WS_YB + (size_t)CAP * D * 2;
constexpr size_t WS_FFN_END = WS_ACT8 + (size_t)CAP * EFF;
constexpr size_t WS_END = WS_MIX_END > WS_FFN_END ? WS_MIX_END : WS_FFN_END;
static_assert(WS_SACT + (size_t)CAP * 4 <= WS_X, "small tables");
static_assert(WS_END <= (size_t)1792 * MiB, "workspace");
static_assert((size_t)T * 3072 * 2 <= (size_t)4 * NCID * 8 * 4096 * 6, "YG fits over ST + PREV");
constexpr int CW_BAR = 4096;

constexpr int RING_BYTES = 131072, LDS_BYTES = 147456, MISC_OFF = LDS_BYTES - 256, NWAVES = 8;

#define LAS __attribute__((address_space(3)))
#define DEVI __device__ __forceinline__
typedef unsigned short bf16;
typedef unsigned v4u __attribute__((ext_vector_type(4)));
typedef unsigned v2u __attribute__((ext_vector_type(2)));
typedef int v4i __attribute__((ext_vector_type(4)));
typedef int v2i __attribute__((ext_vector_type(2)));
typedef float f32x4 __attribute__((ext_vector_type(4)));
#define LDS_WAIT() asm volatile("s_waitcnt lgkmcnt(0)" ::: "memory")
#define VM_WAIT() asm volatile("s_waitcnt vmcnt(0)" ::: "memory")
DEVI unsigned f2bf(float f) { unsigned u = __builtin_bit_cast(unsigned, f); return (u + 0x7fffu + ((u >> 16) & 1u)) >> 16; }
typedef __bf16 bf16n2 __attribute__((ext_vector_type(2)));
typedef float f32n2 __attribute__((ext_vector_type(2)));
DEVI unsigned pk2(float lo, float hi) { const f32n2 v = {lo, hi}; return __builtin_bit_cast(unsigned, __builtin_convertvector(v, bf16n2)); }
DEVI float bfl(unsigned w) { return __uint_as_float(w << 16); }
DEVI float bfh(unsigned w) { return __uint_as_float(w & 0xffff0000u); }
DEVI float silu_f(float x) { return x * __builtin_amdgcn_rcpf(1.0f + __expf(-x)); }
DEVI float wave_sum(float v) {
#pragma unroll
    for (int o = 1; o < 64; o <<= 1) v += __shfl_xor(v, o);
    return v;
}
DEVI void unpack8(const v4u w, float (&f)[8]) { f[0] = bfl(w.x); f[1] = bfh(w.x); f[2] = bfl(w.y); f[3] = bfh(w.y); f[4] = bfl(w.z); f[5] = bfh(w.z); f[6] = bfl(w.w); f[7] = bfh(w.w); }
DEVI v4u pack8(const float (&f)[8]) { v4u w; w.x = pk2(f[0], f[1]); w.y = pk2(f[2], f[3]); w.z = pk2(f[4], f[5]); w.w = pk2(f[6], f[7]); return w; }

#define XB_TMO      128
#define XB_XCNT(j)  (256  + 64 * (j))
#define XB_XSUB(j)  (1280 + 64 * (j))
#define XB_XGEN(j)  (2304 + 64 * (j))
#define XB_TOP      3328
#define XB_TOPGEN   3392
#define XCD_BAR_WORDS 3456
#define XB_SPIN_CAP (1u << 18)

__device__ __forceinline__ unsigned xb_ld(unsigned* p)              { return __hip_atomic_load(p, __ATOMIC_RELAXED, __HIP_MEMORY_SCOPE_AGENT); }
__device__ __forceinline__ unsigned xb_add(unsigned* p, unsigned v) { return __hip_atomic_fetch_add(p, v, __ATOMIC_RELAXED, __HIP_MEMORY_SCOPE_AGENT); }
__device__ __forceinline__ unsigned xb_xcc_id() { return (unsigned)__builtin_amdgcn_s_getreg((3 << 11) | 20) & 0xFu; }
#define XB_SPIN(cond, bar) do { unsigned _sp = 0; while (cond) { __builtin_amdgcn_s_sleep(1); \
    if ((++_sp & 255u) == 0u) { if (xb_ld(&(bar)[XB_TMO])) break; if (_sp > XB_SPIN_CAP) { atomicAdd(&(bar)[XB_TMO], 1u); break; } } } } while (0)

struct XcdBarrier {
    unsigned* bar; unsigned x;
    volatile LAS unsigned* st;
};

__device__ __forceinline__ XcdBarrier xcd_barrier_post(unsigned* bar, volatile LAS unsigned* st) {
    XcdBarrier b; b.bar = bar; b.x = xb_xcc_id(); b.st = st;
    if (threadIdx.x == 0) (void)xb_add(&bar[XB_XCNT(b.x)], 1u);
    return b;
}
__device__ __forceinline__ void xcd_barrier_complete(unsigned* bar, unsigned x, unsigned& nloc, unsigned& nx) {
    const unsigned G = gridDim.x * gridDim.y * gridDim.z;
    unsigned sum, cnt, mine, sp = 0u;
    for (;;) {
        sum = 0u; cnt = 0u; mine = 0u;
#pragma unroll
        for (unsigned j = 0; j < 16; ++j) { const unsigned c = xb_ld(&bar[XB_XCNT(j)]); sum += c; cnt += (c > 0u) ? 1u : 0u; mine = (j == x) ? c : mine; }
        if (sum == G) break;
        __builtin_amdgcn_s_sleep(1);
        if ((++sp & 255u) == 0u) { if (xb_ld(&bar[XB_TMO])) break; if (sp > XB_SPIN_CAP) { atomicAdd(&bar[XB_TMO], 1u); break; } }
    }
    nloc = mine > 0u ? mine : 1u; nx = cnt > 0u ? cnt : 1u;
}

__device__ __forceinline__ void xcd_barrier(const XcdBarrier& b) {
    asm volatile("s_waitcnt vmcnt(0)" ::: "memory");
    __syncthreads();
    if (threadIdx.x == 0) {
        unsigned* bar = b.bar;
        __builtin_amdgcn_s_waitcnt(0);
        unsigned nloc = b.st[0], nx = b.st[1];
        if (nloc == 0u) { xcd_barrier_complete(bar, b.x, nloc, nx); b.st[0] = nloc; b.st[1] = nx; }
        const unsigned old = xb_add(&bar[XB_XSUB(b.x)], 1u);
        const unsigned gen = old / nloc;
        if (old + 1u == (gen + 1u) * nloc) {
            __builtin_amdgcn_fence(__ATOMIC_RELEASE, "agent");
            asm volatile("s_waitcnt vmcnt(0)" ::: "memory");
            const unsigned og = xb_add(&bar[XB_TOP], 1u);
            const unsigned tg = og / nx;
            if (og + 1u == (tg + 1u) * nx) xb_add(&bar[XB_TOPGEN], 1u);
            else XB_SPIN(xb_ld(&bar[XB_TOPGEN]) == tg, bar);
            __builtin_amdgcn_fence(__ATOMIC_ACQUIRE, "agent");
            xb_add(&bar[XB_XGEN(b.x)], 1u);
            asm volatile("s_waitcnt vmcnt(0)" ::: "memory");
        } else {
            XB_SPIN(xb_ld(&bar[XB_XGEN(b.x)]) == gen, bar);
            __builtin_amdgcn_fence(__ATOMIC_ACQUIRE, "agent");
            asm volatile("s_waitcnt vmcnt(0)" ::: "memory");
        }
    }
    __syncthreads();
}
#ifndef REP_PRO
#define REP_PRO 1
#endif
#ifndef REP_P2
#define REP_P2 1
#endif
#ifndef REP_TL
#define REP_TL 1
#endif
#ifndef REP_PREP
#define REP_PREP 1
#endif
#ifndef REP_TR
#define REP_TR 1
#endif
#ifndef REP_ST
#define REP_ST 1
#endif
#ifndef REP_SC
#define REP_SC 1
#endif
#ifndef REP_OUT
#define REP_OUT 1
#endif
#ifndef REP_WIN
#define REP_WIN 1
#endif
#ifndef REP_MRG
#define REP_MRG 1
#endif
#ifndef REP_MOE
#define REP_MOE 1
#endif
#ifndef REP_N1
#define REP_N1 1
#endif
#ifndef REP_N2
#define REP_N2 1
#endif
#ifndef REP_SUM3
#define REP_SUM3 1
#endif
#ifndef REP_GM1
#define REP_GM1 1
#endif
#ifndef REP_GM2
#define REP_GM2 1
#endif
#ifndef REP_QW
#define REP_QW 1
#endif
#ifndef REP_FFN1
#define REP_FFN1 1
#endif
struct Args { const float* in[26]; float* out; unsigned char* ws; };
struct Wv { int tid, lane, wave, vcu, G, gw, NGW; };
#define WV_LOCAL(w0) Wv w = (w0); w.tid = threadIdx.x; asm volatile("" : "+v"(w.tid), "+s"(w.wave), "+s"(w.vcu), "+s"(w.gw), "+s"(w.G), "+s"(w.NGW)); w.lane = w.tid & 63

DEVI int srccol(int mode, int ff, int n) {
    if (mode == 0) return n;
    if (mode == 1) return n < 1280 ? n : (n < 6912 ? n + 16 : (n < 6928 ? n - 6912 + 1280 : -1));
    return (n >> 8) * 128 + (n & 127) + ((n & 128) ? ff : 0);
}
DEVI void tr_item(const float* W, int Nsrc, bf16* WT, int K, int k0, int n0, int mode, int ff, LAS unsigned char* scr, int lane) {
    const int c4 = lane & 15, kr = lane >> 4; const int sc = srccol(mode, ff, n0 + 4 * c4);
#pragma unroll 8
    for (int it = 0; it < 16; ++it) { const int k = it * 4 + kr; f32x4 v = {0.f, 0.f, 0.f, 0.f}; if (sc >= 0) v = *(const f32x4*)(W + (size_t)(k0 + k) * Nsrc + sc);
        v2u o; o.x = pk2(v.x, v.y); o.y = pk2(v.z, v.w); *(LAS v2u*)(scr + k * 136 + c4 * 8) = o; }
    LDS_WAIT(); asm volatile("" ::: "memory");
#pragma unroll 2
    for (int it = 0; it < 8; ++it) { const int q = it * 64 + lane, n = q >> 3, kg = q & 7; unsigned e[8];
#pragma unroll
        for (int i = 0; i < 8; ++i) { const unsigned wv = *(const LAS unsigned*)(scr + (kg * 8 + i) * 136 + (n >> 1) * 4); e[i] = (n & 1) ? (wv >> 16) : (wv & 0xffffu); }
        v4u o; o.x = e[0] | (e[1] << 16); o.y = e[2] | (e[3] << 16); o.z = e[4] | (e[5] << 16); o.w = e[6] | (e[7] << 16);
        *(v4u*)(WT + (size_t)(n0 + n) * K + k0 + kg * 8) = o; }
    LDS_WAIT(); asm volatile("" ::: "memory");
}
struct WqDesc { const float* W; unsigned char* WT; float* sc; float* pmax; int K, Nd, Nsrc, mode, ff; };
DEVI WqDesc wq_desc(const Args& A, unsigned char* ws, int set, int m) {
    WqDesc d;
    if (set == 0)      { d.W = A.in[20] + (size_t)m * 1024 * 5632; d.WT = ws + WS_W13 + (size_t)m * 5632 * 1024; d.sc = (float*)(ws + WS_SB13) + (size_t)m * 5632; d.pmax = (float*)(ws + WS_R) + 0 + (size_t)m * 5632 * 4; d.K = 1024; d.Nd = 5632; d.Nsrc = 5632; d.mode = 2; d.ff = FF; }
    else if (set == 1) { d.W = A.in[23] + (size_t)m * 1024 * 7168; d.WT = ws + WS_M13 + (size_t)m * 7168 * 1024; d.sc = (float*)(ws + WS_SBM) + (size_t)m * 7168; d.pmax = (float*)(ws + WS_R) + 45056 + (size_t)m * 7168 * 4; d.K = 1024; d.Nd = 7168; d.Nsrc = 7168; d.mode = 2; d.ff = EFF; }
    else if (set == 2) { d.W = A.in[8] + (size_t)m * 1024 * 6928; d.WT = ws + WS_WIN + (size_t)m * NP * 1024; d.sc = (float*)(ws + WS_SBW) + (size_t)m * NP; d.pmax = (float*)(ws + WS_R) + 503808 + (size_t)m * NP * 4; d.K = 1024; d.Nd = NP; d.Nsrc = 6928; d.mode = 1; d.ff = 0; }
    else if (set == 3) { d.W = A.in[19] + (size_t)m * 1024 * 1024; d.WT = ws + WS_WOUT + (size_t)m * 1024 * 1024; d.sc = (float*)(ws + WS_SBO) + (size_t)m * 1024; d.pmax = (float*)(ws + WS_R) + 618496 + (size_t)m * 1024 * 4; d.K = 1024; d.Nd = 1024; d.Nsrc = 1024; d.mode = 0; d.ff = 0; }
    else if (set == 4) { d.W = A.in[21] + (size_t)m * 2816 * 1024; d.WT = ws + WS_W2 + (size_t)m * 1024 * 2816; d.sc = (float*)(ws + WS_SB2) + (size_t)m * 1024; d.pmax = (float*)(ws + WS_R) + 634880 + (size_t)m * 1024 * 11; d.K = 2816; d.Nd = 1024; d.Nsrc = 1024; d.mode = 0; d.ff = 0; }
    else               { d.W = A.in[24] + (size_t)m * 3584 * 1024; d.WT = ws + WS_M2 + (size_t)m * 1024 * 3584; d.sc = (float*)(ws + WS_SBM2) + (size_t)m * 1024; d.pmax = (float*)(ws + WS_R) + 657408 + (size_t)m * 1024 * 14; d.K = 3584; d.Nd = 1024; d.Nsrc = 1024; d.mode = 0; d.ff = 0; }
    return d;
}
DEVI void wq_decode(int it, int kind, int& set, int& m, int& q) {
    const int nb[6] = {88, 112, 112, 16, 16, 16}, kb[6] = {16, 16, 16, 16, 44, 56}, nm[6] = {2, 16, 4, 4, 2, 16};
    int r = it;
#pragma unroll
    for (int s_ = 0; s_ < 6; ++s_) { const int per = kind == 1 ? nb[s_] * kb[s_] : nb[s_] * (kb[s_] / 4); const int tot = per * nm[s_]; if (r < tot || s_ == 5) { set = s_; m = r / per; q = r % per; return; } r -= tot; }
}
constexpr int WQ_NSLICE = (2 * 88 + 16 * 112 + 4 * 112 + 4 * 16) * 4 + 2 * 16 * 11 + 16 * 16 * 14;
constexpr int WQ_NITEM = 2 * 88 * 16 + 16 * 112 * 16 + 4 * 112 * 16 + 4 * 16 * 16 + 2 * 16 * 44 + 16 * 16 * 56;
DEVI void wq_colmax(const Args& A, const Wv& w) {
    unsigned char* ws = A.ws;
    for (int t = 9920 + w.gw; t < WQ_NSLICE; t += w.NGW) {
        int set, m, q; wq_decode(t, 2, set, m, q); const WqDesc d = wq_desc(A, ws, set, m);
        const int nbl = d.Nd / 64, nbk = q % nbl, ks = q / nbl;
        const int c4 = w.lane & 15, kr = w.lane >> 4, n = nbk * 64 + 4 * c4; const int sc0 = srccol(d.mode, d.ff, n); const float* wp = d.W + (sc0 >= 0 ? sc0 : 0) + (size_t)(ks * 256 + kr) * d.Nsrc; f32x4 m4 = {0.f, 0.f, 0.f, 0.f};
#pragma unroll 16
        for (int k = 0; k < 64; ++k) { const f32x4 v = *(const f32x4*)(wp + (size_t)(4 * k) * d.Nsrc); m4.x = fmaxf(m4.x, fabsf(v.x)); m4.y = fmaxf(m4.y, fabsf(v.y)); m4.z = fmaxf(m4.z, fabsf(v.z)); m4.w = fmaxf(m4.w, fabsf(v.w)); }
#pragma unroll
        for (int e = 0; e < 4; ++e) { m4[e] = fmaxf(m4[e], __shfl_xor(m4[e], 16)); m4[e] = fmaxf(m4[e], __shfl_xor(m4[e], 32)); }
        if (sc0 < 0) m4 = (f32x4){0.f, 0.f, 0.f, 0.f};
        if (kr == 0) *(f32x4*)(d.pmax + (size_t)ks * d.Nd + n) = m4;
    }
}
DEVI void ph_quant_w(const Args& A, LAS unsigned char* lds, const Wv& w0) {
    WV_LOCAL(w0);
    unsigned char* ws = A.ws; LAS unsigned char* scr = lds + w.wave * 4608;
    for (int it = 39680 + w.gw; it < WQ_NITEM; it += w.NGW) {
        int set, m, q; wq_decode(it, 1, set, m, q); const WqDesc d = wq_desc(A, ws, set, m);
        const int nbl = d.Nd / 64; const int k0 = (q / nbl) * 64, n0 = (q % nbl) * 64;
        const int c4 = w.lane & 15, kr = w.lane >> 4; const int scs = srccol(d.mode, d.ff, n0 + 4 * c4); const int sc = scs >= 0 ? scs : 0;
        f32x4 pm[14];
#pragma unroll
        for (int ks = 0; ks < 14; ++ks) { const int kc = ks < d.K / 256 ? ks : 0; pm[ks] = *(const f32x4*)(d.pmax + (size_t)kc * d.Nd + n0 + 4 * c4); }
        f32x4 m4 = pm[0];
#pragma unroll
        for (int ks = 1; ks < 14; ++ks) { m4.x = fmaxf(m4.x, pm[ks].x); m4.y = fmaxf(m4.y, pm[ks].y); m4.z = fmaxf(m4.z, pm[ks].z); m4.w = fmaxf(m4.w, pm[ks].w); }
        if (k0 == 0 && kr == 0) *(f32x4*)(d.sc + n0 + 4 * c4) = m4 * (1.0f / 224.0f);
        f32x4 inv;
#pragma unroll
        for (int e = 0; e < 4; ++e) inv[e] = m4[e] > 0.f ? 224.0f / m4[e] : 0.f;
#pragma unroll 8
        for (int i = 0; i < 16; ++i) { const int k = i * 4 + kr; const f32x4 v = *(const f32x4*)(d.W + (size_t)(k0 + k) * d.Nsrc + sc);
            int pq = __builtin_amdgcn_cvt_pk_fp8_f32(v.x * inv.x, v.y * inv.y, 0, false); pq = __builtin_amdgcn_cvt_pk_fp8_f32(v.z * inv.z, v.w * inv.w, pq, true);
            *(LAS unsigned*)(scr + k * 68 + c4 * 4) = (unsigned)pq; }
        LDS_WAIT(); asm volatile("" ::: "memory");
#pragma unroll 2
        for (int i = 0; i < 4; ++i) { const int p = i * 64 + w.lane, n = p >> 2, kg = p & 3; unsigned o[4];
#pragma unroll
            for (int dd = 0; dd < 4; ++dd) { unsigned v = 0;
#pragma unroll
                for (int b = 0; b < 4; ++b) v |= (unsigned)scr[(kg * 16 + dd * 4 + b) * 68 + n] << (8 * b);
                o[dd] = v; }
            v4u ov; ov.x = o[0]; ov.y = o[1]; ov.z = o[2]; ov.w = o[3];
            *(v4u*)(d.WT + (size_t)(n0 + n) * d.K + k0 + kg * 16) = ov; }
        LDS_WAIT(); asm volatile("" ::: "memory");
    }
}

template <int W>
DEVI void ph_quant_act(const bf16* src, unsigned char* dst, float* scale, int row_start, int row_end, const Wv& w0) {
    WV_LOCAL(w0);
    constexpr int NV = W / 8, NI = (NV + 63) / 64;
    for (int row = row_start + w.gw; row < row_end; row += w.NGW) {
        v4u v[NI]; float am = 0.f;
#pragma unroll
        for (int i = 0; i < NI; ++i) { const int vi = i * 64 + w.lane; v[i] = (v4u){0u, 0u, 0u, 0u}; if (vi < NV) v[i] = *(const v4u*)(src + (size_t)row * W + vi * 8); }
#pragma unroll
        for (int i = 0; i < NI; ++i) { float f[8]; unpack8(v[i], f);
#pragma unroll
            for (int e = 0; e < 8; ++e) am = fmaxf(am, fabsf(f[e])); }
#pragma unroll
        for (int o = 1; o < 64; o <<= 1) am = fmaxf(am, __shfl_xor(am, o));
        const float inv = am > 0.f ? 127.0f / am : 0.f;
#pragma unroll
        for (int i = 0; i < NI; ++i) { const int vi = i * 64 + w.lane; if (vi < NV) { float f[8]; unpack8(v[i], f); int qv[8];
#pragma unroll
                for (int e = 0; e < 8; ++e) qv[e] = (int)rintf(f[e] * inv) & 255;
                v2u o; o.x = (unsigned)qv[0] | ((unsigned)qv[1] << 8) | ((unsigned)qv[2] << 16) | ((unsigned)qv[3] << 24); o.y = (unsigned)qv[4] | ((unsigned)qv[5] << 8) | ((unsigned)qv[6] << 16) | ((unsigned)qv[7] << 24);
                *(v2u*)(dst + (size_t)row * W + vi * 8) = o; } }
        if (w.lane == 0) scale[row] = am * (1.0f / 127.0f);
    }
}

DEVI void wq_single(const Args& A, LAS unsigned char* lds, const Wv& w) {
    unsigned char* ws = A.ws; LAS float* tile = (LAS float*)lds; LAS float* pm = (LAS float*)(lds + 135168); LAS float* mx = pm + 512;
    for (int t0 = w.vcu; t0 < 4960; t0 += w.G) {
        int t = t0, set, m, nb;
        if (t < 352) { set = 0; m = t / 176; nb = t % 176; } else if ((t -= 352) < 3584) { set = 1; m = t / 224; nb = t % 224; } else if ((t -= 3584) < 896) { set = 2; m = t / 224; nb = t % 224; } else { t -= 896; set = 3; m = t / 32; nb = t % 32; }
        const WqDesc d = wq_desc(A, ws, set, m); const int n0 = nb * 32;
        { const int c4 = w.tid & 7; const int sc0 = srccol(d.mode, d.ff, n0 + 4 * c4); const float* wp = d.W + (sc0 >= 0 ? sc0 : 0);
#pragma unroll 8
          for (int it = 0; it < 16; ++it) { const int k = it * 64 + (w.tid >> 3); f32x4 v = *(const f32x4*)(wp + (size_t)k * d.Nsrc); if (sc0 < 0) v = (f32x4){0.f, 0.f, 0.f, 0.f};
            LAS float* tp = tile + k * 33 + 4 * c4; tp[0] = v.x; tp[1] = v.y; tp[2] = v.z; tp[3] = v.w; } }
        __syncthreads();
        const int n = w.tid & 31, sl = w.tid >> 5;
        { float a = 0.f;
#pragma unroll 16
          for (int i = 0; i < 64; ++i) a = fmaxf(a, fabsf(tile[(sl * 64 + i) * 33 + n]));
          pm[sl * 32 + n] = a; }
        __syncthreads();
        if (w.tid < 32) { float a = pm[w.tid];
#pragma unroll
            for (int q = 1; q < 16; ++q) a = fmaxf(a, pm[q * 32 + w.tid]);
            mx[w.tid] = a; d.sc[n0 + w.tid] = a * (1.0f / 127.0f); }
        __syncthreads();
        { const float a = mx[n]; const float inv = a > 0.f ? 127.0f / a : 0.f; unsigned char* op = d.WT + (size_t)(n0 + n) * 1024 + sl * 64;
#pragma unroll
          for (int p = 0; p < 4; ++p) { unsigned o[4];
#pragma unroll
            for (int dd = 0; dd < 4; ++dd) { unsigned v = 0;
#pragma unroll
                for (int b = 0; b < 4; ++b) v |= ((unsigned)((int)rintf(tile[(sl * 64 + p * 16 + dd * 4 + b) * 33 + n] * inv) & 255)) << (8 * b);
                o[dd] = v; }
            v4u ov; ov.x = o[0]; ov.y = o[1]; ov.z = o[2]; ov.w = o[3]; *(v4u*)(op + p * 16) = ov; } }
        __syncthreads();
    }
}
DEVI void ph_prologue(const Args& A, LAS unsigned char* lds, const Wv& w0) {
    WV_LOCAL(w0);
    unsigned char* ws = A.ws;
    LAS float* sc = (LAS float*)lds;
    for (int i = w.tid; i < 5 * 1024; i += 512) { const int v = i >> 10, k = i & 1023; const float c = v < 4 ? A.in[1][v * 1024 + k] : A.in[3][k]; sc[i] = silu_f(c); }
    __syncthreads();
    float* MOD = (float*)(ws + WS_MOD);
    for (int u = w.gw; u < 1536; u += w.NGW) { const int layer = u / 384, c = w.lane & 15, kq = w.lane >> 4, col = (u % 384) * 16 + c;
        const float* wp = A.in[4] + (size_t)layer * 1024 * 6144 + (size_t)(kq * 256) * 6144 + col; const LAS float* sk = sc + kq * 256; float a0 = 0.f, a1 = 0.f, a2 = 0.f, a3 = 0.f, a4 = 0.f;
#pragma unroll 16
        for (int k = 0; k < 256; ++k) { const float wv = wp[(size_t)k * 6144]; a0 += sk[k] * wv; a1 += sk[1024 + k] * wv; a2 += sk[2048 + k] * wv; a3 += sk[3072 + k] * wv; a4 += sk[4096 + k] * wv; }
        a0 += __shfl_xor(a0, 16); a1 += __shfl_xor(a1, 16); a2 += __shfl_xor(a2, 16); a3 += __shfl_xor(a3, 16); a4 += __shfl_xor(a4, 16);
        a0 += __shfl_xor(a0, 32); a1 += __shfl_xor(a1, 32); a2 += __shfl_xor(a2, 32); a3 += __shfl_xor(a3, 32); a4 += __shfl_xor(a4, 32);
        if (kq == 0) { const float b = A.in[5][layer * 6144 + col]; float* m = MOD + (size_t)layer * 5 * 6144 + col;
            m[0] = a0 + b; m[6144] = a1 + b; m[2 * 6144] = a2 + b; m[3 * 6144] = a3 + b; m[4 * 6144] = a4 + b; } }
    if (w.gw < 48) { const int e = w.gw * 64 + w.lane, pos = e >> 4, ai = e & 15; const float inv = powf(10000.0f, -(float)ai * (1.0f / 16.0f)); const float ang = (float)(pos < 128 ? pos : pos - 128) * inv; float sn, cs_; sincosf(ang, &sn, &cs_);
        ((float*)(ws + WS_ROPE))[2 * e] = cs_; ((float*)(ws + WS_ROPE))[2 * e + 1] = sn; }
    LAS unsigned char* scr = lds + 32768 + w.wave * 8704;
    constexpr int N0 = 0, N1 = 1024, N2 = 0, N3 = 0, N4 = 0, N5 = 0, N6 = 0, NITEMS = N0 + N1 + N2 + N3 + N4 + N5 + N6;
    for (int it = w.gw; it < NITEMS; it += w.NGW) {
        int r = it; const float* W; bf16* WT; int Nsrc, K, k0, n0, mode = 0, ff = 0;
        if (r < N0) { const int layer = r / 1792, q = r % 1792; W = A.in[8] + (size_t)layer * 1024 * 6928; Nsrc = 6928; WT = (bf16*)(ws + WS_WIN) + (size_t)layer * NP * 1024; K = 1024; k0 = (q / 112) * 64; n0 = (q % 112) * 64; mode = 1; }
        else if ((r -= N0) < N1) { const int m = r / 128, layer = m >> 1, i = (m & 1) * 2, q = r % 128; W = A.in[18] + (size_t)(layer * 3 + i) * 512 * 1024; Nsrc = 1024; WT = (bf16*)(ws + WS_WBR) + (size_t)(layer * 3 + i) * 1024 * 512; K = 512; k0 = (q / 16) * 64; n0 = (q % 16) * 64; }
        else if ((r -= N1) < N2) { const int layer = r / 256, q = r % 256; W = A.in[19] + (size_t)layer * 1024 * 1024; Nsrc = 1024; WT = (bf16*)(ws + WS_WOUT) + (size_t)layer * 1024 * 1024; K = 1024; k0 = (q / 16) * 64; n0 = (q % 16) * 64; }
        else if ((r -= N2) < N3) { const int l2 = r / 1408, q = r % 1408; W = A.in[20] + (size_t)l2 * 1024 * 5632; Nsrc = 5632; WT = (bf16*)(ws + WS_W13) + (size_t)l2 * 5632 * 1024; K = 1024; k0 = (q / 88) * 64; n0 = (q % 88) * 64; mode = 2; ff = FF; }
        else if ((r -= N3) < N4) { const int l2 = r / 704, q = r % 704; W = A.in[21] + (size_t)l2 * 2816 * 1024; Nsrc = 1024; WT = (bf16*)(ws + WS_W2) + (size_t)l2 * 1024 * 2816; K = 2816; k0 = (q / 16) * 64; n0 = (q % 16) * 64; }
        else if ((r -= N4) < N5) { const int m = r / 1792, q = r % 1792; W = A.in[23] + (size_t)m * 1024 * 7168; Nsrc = 7168; WT = (bf16*)(ws + WS_M13) + (size_t)m * 7168 * 1024; K = 1024; k0 = (q / 112) * 64; n0 = (q % 112) * 64; mode = 2; ff = EFF; }
        else { r -= N5; const int m = r / 896, q = r % 896; W = A.in[24] + (size_t)m * 3584 * 1024; Nsrc = 1024; WT = (bf16*)(ws + WS_M2) + (size_t)m * 1024 * 3584; K = 3584; k0 = (q / 16) * 64; n0 = (q % 16) * 64; }
        tr_item(W, Nsrc, WT, K, k0, n0, mode, ff, scr, w.lane);
    }
    wq_colmax(A, w);
    for (int it = w.gw; it < 4096; it += w.NGW) {
        const int layer = it >> 10, r = it & 1023, gi = r >> 8, ib = (r >> 4) & 15, db = r & 15, d = db * 64 + w.lane, i0 = ib * 8;
        const float* pw = A.in[15] + ((size_t)(layer * 4 + gi) * 128 + i0) * 128; const float* ps = A.in[16] + layer * 512 + gi * 128;
        const float* wb = A.in[18] + ((size_t)(layer * 3 + 1) * 512 + gi * 128) * 1024 + d;
        float acc[8] = {0.f, 0.f, 0.f, 0.f, 0.f, 0.f, 0.f, 0.f};
#pragma unroll 16
        for (int j = 0; j < 128; ++j) { const float wv = wb[(size_t)j * 1024] * ps[j];
#pragma unroll
            for (int i = 0; i < 8; ++i) acc[i] += pw[i * 128 + j] * wv; }
        *(v4u*)((bf16*)(ws + WS_WBR) + ((size_t)(layer * 3 + 1) * 1024 + d) * 512 + gi * 128 + i0) = pack8(acc);
    }
    __syncthreads();
    wq_single(A, lds, w);
}

template <int MODE, bool COMBINE, bool ROUTER, bool Q8 = false>
DEVI void ph_norm(const Args& A, const Wv& w0, int layer, int prev, int row_start = 0, bool from_inputs = false) {
    WV_LOCAL(w0);
    unsigned char* ws = A.ws;
    bf16* X = (bf16*)(ws + WS_X); bf16* ABF = (bf16*)(ws + WS_ABF); const float* MOD = (const float*)(ws + WS_MOD);
    const float* YB = (const float*)(ws + WS_YB); const v4i* ROUTE = (const v4i*)(ws + WS_ROUTE); const v2i* SLOT = (const v2i*)(ws + WS_SLOT);
    f32x4 rw[ROUTER ? 4 : 1][4][2];
    if (ROUTER) { const float* wr = A.in[22] + (size_t)(layer >> 1) * D * 8;
#pragma unroll
        for (int j = 0; j < 4; ++j)
#pragma unroll
            for (int i = 0; i < 4; ++i) { const int col = j * 256 + w.lane * 4 + i; rw[ROUTER ? j : 0][i][0] = *(const f32x4*)(wr + col * 8); rw[ROUTER ? j : 0][i][1] = *(const f32x4*)(wr + col * 8 + 4); } }
    f32x4 gnv[4], shv[4], scv[4], g2v[4]; int vcur = -1;
    { const float* gn = (MODE == 2 ? A.in[25] : A.in[MODE == 0 ? 6 : 7] + layer * D) + w.lane * 4;
#pragma unroll
      for (int j = 0; j < 4; ++j) { gnv[j] = *(const f32x4*)(gn + j * 256); shv[j] = gnv[j]; scv[j] = gnv[j]; g2v[j] = gnv[j]; } }
#pragma unroll 2
    for (int row = row_start + w.gw; row < T; row += w.NGW) {
        if (MODE == 2 && row < NCTX) continue;
        const int v = row < NCTX ? 4 : ((row - NCTX) >> 13);
        if (v != vcur) { vcur = v;
            if (MODE != 2) { const float* md = MOD + ((size_t)layer * 5 + v) * 6144 + (MODE == 0 ? 0 : 3072) + w.lane * 4;
#pragma unroll
                for (int j = 0; j < 4; ++j) { shv[j] = *(const f32x4*)(md + j * 256); scv[j] = *(const f32x4*)(md + 1024 + j * 256); } }
            if (COMBINE) { const float* g2 = MOD + ((size_t)prev * 5 + v) * 6144 + 5120 + w.lane * 4;
#pragma unroll
                for (int j = 0; j < 4; ++j) g2v[j] = *(const f32x4*)(g2 + j * 256); } }
        bf16* xr = X + (size_t)row * D + w.lane * 4;
        f32x4 xv[4];
        if (from_inputs) {
            const float* xs = (row < NCTX ? A.in[2] + (size_t)row * D : A.in[0] + (size_t)(row - NCTX) * D) + w.lane * 4;
#pragma unroll
            for (int j = 0; j < 4; ++j) xv[j] = *(const f32x4*)(xs + j * 256);
        } else {
            v2u xw[4];
#pragma unroll
            for (int j = 0; j < 4; ++j) xw[j] = *(const v2u*)(xr + j * 256);
#pragma unroll
            for (int j = 0; j < 4; ++j) { xv[j].x = bfl(xw[j].x); xv[j].y = bfh(xw[j].x); xv[j].z = bfl(xw[j].y); xv[j].w = bfh(xw[j].y); }
        }
        if (COMBINE) {
            const v4i rt = ROUTE[row]; const v2i sl = SLOT[row]; const float w0 = __int_as_float(rt.z), w1 = __int_as_float(rt.w);
            const bf16* y0 = (const bf16*)YB + (size_t)sl.x * D + w.lane * 4; const bf16* y1 = (const bf16*)YB + (size_t)sl.y * D + w.lane * 4;
#pragma unroll
            for (int j = 0; j < 4; ++j) { const v2u aw = *(const v2u*)(y0 + j * 256), bw = *(const v2u*)(y1 + j * 256); const f32x4 a = {bfl(aw.x), bfh(aw.x), bfl(aw.y), bfh(aw.y)}, b = {bfl(bw.x), bfh(bw.x), bfl(bw.y), bfh(bw.y)}, g = g2v[j];
                xv[j] = xv[j] + g * (a * w0 + b * w1); if (MODE != 2) { v2u o; o.x = pk2(xv[j].x, xv[j].y); o.y = pk2(xv[j].z, xv[j].w); *(v2u*)(xr + j * 256) = o; } }
        }
        float ss = 0.f;
#pragma unroll
        for (int j = 0; j < 4; ++j) ss += (xv[j].x * xv[j].x + xv[j].y * xv[j].y) + (xv[j].z * xv[j].z + xv[j].w * xv[j].w);
        ss = wave_sum(ss);
        const float r = 1.0f / sqrtf(ss * (1.0f / D) + EPS);
        if (MODE == 2) {
            float* o = A.out + (size_t)(row - NCTX) * D + w.lane * 4;
#pragma unroll
            for (int j = 0; j < 4; ++j) *(f32x4*)(o + j * 256) = xv[j] * r * gnv[j];
            continue;
        }
        f32x4 h[4];
#pragma unroll
        for (int j = 0; j < 4; ++j) { const f32x4 g = gnv[j], sh = shv[j], sc = scv[j];
            h[j] = (xv[j] * r * g) * (sc + 1.0f) + sh;
            if (!Q8) { v2u o; o.x = pk2(h[j].x, h[j].y); o.y = pk2(h[j].z, h[j].w); *(v2u*)(ABF + (size_t)row * D + j * 256 + w.lane * 4) = o; } }
        if (Q8) {
            float am = 0.f;
#pragma unroll
            for (int j = 0; j < 4; ++j) am = fmaxf(fmaxf(am, fmaxf(fabsf(h[j].x), fabsf(h[j].y))), fmaxf(fabsf(h[j].z), fabsf(h[j].w)));
#pragma unroll
            for (int o = 1; o < 64; o <<= 1) am = fmaxf(am, __shfl_xor(am, o));
            const float inv = am > 0.f ? 127.0f / am : 0.f;
#pragma unroll
            for (int j = 0; j < 4; ++j) { const int q0 = (int)rintf(h[j].x * inv), q1 = (int)rintf(h[j].y * inv), q2 = (int)rintf(h[j].z * inv), q3 = (int)rintf(h[j].w * inv);
                *(unsigned*)((unsigned char*)ABF + (size_t)row * D + j * 256 + w.lane * 4) = (unsigned)(q0 & 255) | ((unsigned)(q1 & 255) << 8) | ((unsigned)(q2 & 255) << 16) | ((unsigned)(q3 & 255) << 24); }
            if (w.lane == 0) ((float*)(ws + WS_SA))[row] = am * (1.0f / 127.0f);
        }
        if (ROUTER) {
            float lg[8] = {0.f, 0.f, 0.f, 0.f, 0.f, 0.f, 0.f, 0.f};
#pragma unroll
            for (int j = 0; j < 4; ++j)
#pragma unroll
                for (int i = 0; i < 4; ++i) { const f32x4 wa = rw[ROUTER ? j : 0][i][0], wb = rw[ROUTER ? j : 0][i][1]; const float hv = h[j][i];
                    lg[0] += hv * wa.x; lg[1] += hv * wa.y; lg[2] += hv * wa.z; lg[3] += hv * wa.w; lg[4] += hv * wb.x; lg[5] += hv * wb.y; lg[6] += hv * wb.z; lg[7] += hv * wb.w; }
#pragma unroll
            for (int e = 0; e < 8; ++e) lg[e] = wave_sum(lg[e]);
            int e0 = 0; float v0 = lg[0];
#pragma unroll
            for (int e = 1; e < 8; ++e) if (lg[e] > v0) { v0 = lg[e]; e0 = e; }
            int e1 = -1; float v1 = -3.0e38f;
#pragma unroll
            for (int e = 0; e < 8; ++e) if (e != e0 && lg[e] > v1) { v1 = lg[e]; e1 = e; }
            const float ex = __expf(v1 - v0), w0 = 1.0f / (1.0f + ex), w1 = ex / (1.0f + ex);
            if (w.lane == 0) { v4i rt; rt.x = e0; rt.y = e1; rt.z = __float_as_int(w0); rt.w = __float_as_int(w1); ((v4i*)(ws + WS_ROUTE))[row] = rt; }
        }
    }
}

DEVI void seq_of_row(int row, int& base, int& t, int& L) { if (row < NCTX) { base = row & ~(CTXL - 1); t = row & (CTXL - 1); L = CTXL; } else { const int q = row - NCTX; base = NCTX + (q & ~(SEQ - 1)); t = q & (SEQ - 1); L = SEQ; } }
DEVI void ph_prep(const Args& A, const Wv& w0, int layer) {
    WV_LOCAL(w0);
    unsigned char* ws = A.ws; const bf16* P = (const bf16*)(ws + WS_P);
    const int gt = w.gw * 64 + w.lane, NT_ = w.NGW * 64;
    { bf16* XBC = (bf16*)(ws + WS_XBC); const float* cw = A.in[9] + (size_t)layer * 5 * 768; const float* cb = A.in[10] + layer * 768;
#pragma unroll 4
      for (int it = gt; it < T * 96; it += NT_) { const int row = it / 96, c = (it % 96) * 8; int base, t, L; seq_of_row(row, base, t, L);
        float acc[8];
#pragma unroll
        for (int i = 0; i < 8; ++i) acc[i] = cb[c + i];
#pragma unroll
        for (int k = 0; k < 5; ++k) { const int tt = t + k - 2; if (tt >= 0 && tt < L) { float u[8]; unpack8(*(const v4u*)(P + (size_t)(base + tt) * PW + PC_XBC + c), u);
#pragma unroll
            for (int i = 0; i < 8; ++i) acc[i] += cw[k * 768 + c + i] * u[i]; } }
#pragma unroll
        for (int i = 0; i < 8; ++i) acc[i] = silu_f(acc[i]);
        *(v4u*)(XBC + (size_t)row * 768 + c) = pack8(acc); } }
    { float* DTT = (float*)(ws + WS_DTT); const float* db = A.in[11] + layer * 16;
#pragma unroll 4
      for (int it = gt; it < NCID * 16 * 128; it += NT_) { const int l = it & 127, j = (it >> 7) & 15, cid = it >> 11; const int b = cid / NCH, c = cid % NCH; const int row = (c < 2 ? b * CTXL + c * 128 : NCTX + b * SEQ + (c - 2) * 128) + l;
        const float x = __uint_as_float((unsigned)P[(size_t)row * PW + PC_DT + j] << 16) + db[j];
        DTT[it] = x > 20.f ? x : log1pf(expf(x)); } }
    { bf16* QR = (bf16*)(ws + WS_QR); bf16* KR = (bf16*)(ws + WS_KR);
#pragma unroll 4
      for (int it = gt; it < T * 64; it += NT_) { const int row = it >> 6, r = it & 63, which = r >> 5, h = (r >> 2) & 7, pv = r & 3;
        const bf16* src = P + (size_t)row * PW + (which ? PC_K : PC_Q) + h * 64 + pv * 8; float x1[8], x2[8], o1[8], o2[8]; unpack8(*(const v4u*)src, x1); unpack8(*(const v4u*)(src + 32), x2);
        const float scl = which ? 0.125f : 1.0f;
        if (row >= NCTX) { const int t = (row - NCTX) & (SEQ - 1); const int pos = (pv < 2) ? (t >> 6) : 128 + (t & 63);
            const float* tab = (const float*)(ws + WS_ROPE) + ((size_t)pos * 16 + (pv & 1) * 8) * 2;
#pragma unroll
            for (int i = 0; i < 8; i += 2) { const f32x4 cs4 = *(const f32x4*)(tab + 2 * i);
                o1[i] = (x1[i] * cs4.x - x2[i] * cs4.y) * scl; o2[i] = (x1[i] * cs4.y + x2[i] * cs4.x) * scl; o1[i + 1] = (x1[i + 1] * cs4.z - x2[i + 1] * cs4.w) * scl; o2[i + 1] = (x1[i + 1] * cs4.w + x2[i + 1] * cs4.z) * scl; } }
        else {
#pragma unroll
            for (int i = 0; i < 8; ++i) { o1[i] = x1[i] * scl; o2[i] = x2[i] * scl; } }
        bf16* dst = (which ? KR : QR) + (size_t)row * 512 + h * 64 + pv * 8; *(v4u*)dst = pack8(o1); *(v4u*)(dst + 32) = pack8(o2); } }
    { bf16* AB1 = (bf16*)(ws + WS_ABR) + (size_t)T * 512;
#pragma unroll 2
      for (int it = gt; it < T * 64; it += NT_) { const int row = it >> 6, c = (it & 63) * 8, gi = c >> 7, wd = 2 << gi, left = wd >> 1, right = wd - 1 - left; int base, t, L; seq_of_row(row, base, t, L);
        const int lo = t - left > 0 ? t - left : 0, hi = t + right < L - 1 ? t + right : L - 1;
        float s[8] = {0.f, 0.f, 0.f, 0.f, 0.f, 0.f, 0.f, 0.f}, u0[8];
        v4u uw[16];
#pragma unroll
        for (int k = 0; k < 16; ++k) { const int tt = t - 8 + k; const int tc = tt < lo ? lo : (tt > hi ? hi : tt); uw[k] = *(const v4u*)(P + (size_t)(base + tc) * PW + PC_POOL + c); }
#pragma unroll
        for (int k = 0; k < 16; ++k) { const int tt = t - 8 + k; if (tt >= lo && tt <= hi) { float u[8]; unpack8(uw[k], u);
#pragma unroll
                for (int i = 0; i < 8; ++i) s[i] += u[i]; } }
        unpack8(uw[8], u0); const float rc = 1.0f / (float)(hi - lo + 1);
#pragma unroll
        for (int i = 0; i < 8; ++i) s[i] = s[i] * rc - u0[i];
        *(v4u*)(AB1 + (size_t)row * 512 + c) = pack8(s); } }
}
DEVI void ph_prep2(const Args& A, const Wv& w0, int layer) {
    WV_LOCAL(w0);
    unsigned char* ws = A.ws; const bf16* P = (const bf16*)(ws + WS_P);
    const int gt = w.gw * 64 + w.lane, NT_ = w.NGW * 64;
    { float* DTT = (float*)(ws + WS_DTT); const float* db = A.in[11] + layer * 16;
#pragma unroll 4
      for (int it = gt; it < NCID * 16 * 128; it += NT_) { const int l = it & 127, j = (it >> 7) & 15, cid = it >> 11; const int b = cid / NCH, c = cid % NCH; const int row = (c < 2 ? b * CTXL + c * 128 : NCTX + b * SEQ + (c - 2) * 128) + l;
        const float x = __uint_as_float((unsigned)P[(size_t)row * PW + PC_DT + j] << 16) + db[j];
        DTT[it] = x > 20.f ? x : log1pf(expf(x)); } }
    { bf16* AB1 = (bf16*)(ws + WS_ABR) + (size_t)T * 512;
      v4u uw[16];
      auto issue = [&](int it) { const int row = it >> 6, c = (it & 63) * 8, gi = c >> 7, wd = 2 << gi, left = wd >> 1, right = wd - 1 - left; int base, t, L; seq_of_row(row, base, t, L);
          const int lo = t - left > 0 ? t - left : 0, hi = t + right < L - 1 ? t + right : L - 1;
#pragma unroll
          for (int k = 0; k < 16; ++k) { const int tt = t - 8 + k; const int tc = tt < lo ? lo : (tt > hi ? hi : tt); uw[k] = *(const v4u*)(P + (size_t)(base + tc) * PW + PC_POOL + c); } };
      int it = gt; if (it < T * 64) issue(it);
#pragma unroll 1
      for (; it < T * 64; it += NT_) { const int row = it >> 6, c = (it & 63) * 8, gi = c >> 7, wd = 2 << gi, left = wd >> 1, right = wd - 1 - left; int base, t, L; seq_of_row(row, base, t, L);
        const int lo = t - left > 0 ? t - left : 0, hi = t + right < L - 1 ? t + right : L - 1;
        float s[8] = {0.f, 0.f, 0.f, 0.f, 0.f, 0.f, 0.f, 0.f}, u0[8];
#pragma unroll
        for (int k = 0; k < 16; ++k) { const int tt = t - 8 + k; if (tt >= lo && tt <= hi) { float u[8]; unpack8(uw[k], u);
#pragma unroll
                for (int i = 0; i < 8; ++i) s[i] += u[i]; } }
        unpack8(uw[8], u0); const float rc = 1.0f / (float)(hi - lo + 1);
#pragma unroll
        for (int i = 0; i < 8; ++i) s[i] = s[i] * rc - u0[i];
        asm volatile("" ::: "memory");
        if (it + NT_ < T * 64) issue(it + NT_);
        asm volatile("" ::: "memory");
        *(v4u*)(AB1 + (size_t)row * 512 + c) = pack8(s); } }
}

typedef short bf16x8 __attribute__((ext_vector_type(8)));
typedef float f32x16 __attribute__((ext_vector_type(16)));
#define MFMA32(a, b, c) __builtin_amdgcn_mfma_f32_32x32x16_bf16((a), (b), (c), 0, 0, 0)
DEVI int chunk_row0(int cid) { const int b = cid / NCH, c = cid % NCH; return c < 2 ? b * CTXL + c * 128 : NCTX + b * SEQ + (c - 2) * 128; }
DEVI bf16x8 ld8(const bf16* p) { return __builtin_bit_cast(bf16x8, *(const v4u*)p); }
DEVI bf16x8 ld4x2(const bf16* p0, const bf16* p1) { const v2u a = *(const v2u*)p0, b = *(const v2u*)p1; v4u w; w.x = a.x; w.y = a.y; w.z = b.x; w.w = b.y; return __builtin_bit_cast(bf16x8, w); }

DEVI void ph_transpose(const Args& A, LAS unsigned char* lds, const Wv& w0) {
    WV_LOCAL(w0);
    unsigned char* ws = A.ws;
    LAS unsigned* tile = (LAS unsigned*)(lds + w.wave * 16896);
    for (int task = w.gw; task < NCID * 46; task += w.NGW) {
        const int cid = task / 46, m = task % 46, row0 = chunk_row0(cid);
        const bf16* src; int stride; bool typeX;
        if (m < 2) { src = (const bf16*)(ws + WS_XBC) + (size_t)row0 * 768 + 640 + m * 64; stride = 768; typeX = false; }
        else if (m < 6) { src = (const bf16*)(ws + WS_XBC) + (size_t)row0 * 768 + 512 + (m & 1) * 64; stride = 768; typeX = m >= 4; }
        else if (m < 14) { src = (const bf16*)(ws + WS_XBC) + (size_t)row0 * 768 + (m - 6) * 64; stride = 768; typeX = true; }
        else if (m < 22) { src = (const bf16*)(ws + WS_QR) + (size_t)row0 * 512 + (m - 14) * 64; stride = 512; typeX = false; }
        else if (m < 38) { src = (const bf16*)(ws + WS_KR) + (size_t)row0 * 512 + ((m - 22) & 7) * 64; stride = 512; typeX = m >= 30; }
        else { src = (const bf16*)(ws + WS_P) + (size_t)row0 * PW + PC_V + (m - 38) * 64; stride = PW; typeX = true; }
        bf16* dst = (bf16*)(ws + WS_FR) + ((size_t)cid * 46 + m) * 8192;
        if (!typeX) {
#pragma unroll 4
            for (int it = 0; it < 16; ++it) { const int q = it * 64 + w.lane, row = q >> 3, pc = q & 7; const v4u v = *(const v4u*)(src + (size_t)row * stride + pc * 8);
                *(v4u*)(dst + ((((row >> 5) * 4 + (pc >> 1)) * 64) + (pc & 1) * 32 + (row & 31)) * 8) = v; }
        } else {
#pragma unroll 4
            for (int it = 0; it < 16; ++it) { const int q = it * 64 + w.lane, row = q >> 3, pc = q & 7; const v4u v = *(const v4u*)(src + (size_t)row * stride + pc * 8);
                LAS unsigned* t = tile + row * 33 + pc * 4; t[0] = v.x; t[1] = v.y; t[2] = v.z; t[3] = v.w; }
            LDS_WAIT(); asm volatile("" ::: "memory");
#pragma unroll 2
            for (int it = 0; it < 16; ++it) {
                const int ct = it >> 3, i = (it >> 1) & 3, kk = it & 1, r = w.lane & 31, hh = w.lane >> 5, col = 32 * ct + r, rb = 32 * i + 16 * kk + 4 * hh; unsigned e[8];
#pragma unroll
                for (int jj = 0; jj < 8; ++jj) { const unsigned wv = tile[(rb + 8 * (jj >> 2) + (jj & 3)) * 33 + (col >> 1)]; e[jj] = (col & 1) ? (wv >> 16) : (wv & 0xffffu); }
                v4u o; o.x = e[0] | (e[1] << 16); o.y = e[2] | (e[3] << 16); o.z = e[4] | (e[5] << 16); o.w = e[6] | (e[7] << 16);
                *(v4u*)(dst + (it * 64 + w.lane) * 8) = o; }
            LDS_WAIT(); asm volatile("" ::: "memory");
        }
    }
}

struct TileTask { int cid, t, row0, cc, ts0, L, srccol, tR, tX, rmcol; bool conv, rope; float scl; };
DEVI TileTask tiles_decode(int task) {
    TileTask k; k.cid = task / 36; k.t = task % 36; k.row0 = chunk_row0(k.cid); k.cc = k.cid % NCH;
    k.ts0 = k.cc < 2 ? k.cc * 128 : (k.cc - 2) * 128; k.L = k.cc < 2 ? CTXL : SEQ;
    k.tR = -1; k.tX = -1; k.rmcol = -1; k.conv = false; k.rope = false; k.scl = 1.0f; const int t = k.t;
    if (t < 12) { k.conv = true; k.srccol = PC_XBC + t * 64; if (t < 8) { k.rmcol = t * 64; k.tX = 6 + t; } else if (t < 10) { k.tR = 2 + (t - 8); k.tX = 4 + (t - 8); } else k.tR = t - 10; }
    else if (t < 20) { k.rope = true; k.srccol = PC_Q + (t - 12) * 64; k.tR = 14 + (t - 12); }
    else if (t < 28) { k.rope = true; k.srccol = PC_K + (t - 20) * 64; k.tR = 22 + (t - 20); k.tX = 30 + (t - 20); k.scl = 0.125f; }
    else { k.srccol = PC_V + (t - 28) * 64; k.tX = 38 + (t - 28); }
    return k;
}
DEVI void tiles_flush(unsigned char* ws, const TileTask& k, int half, const LAS unsigned* tile, int lane) {
    if (k.rmcol >= 0) {
#pragma unroll 4
        for (int it = 0; it < 8; ++it) { const int row = 64 * half + it * 8 + (lane >> 3), pc = lane & 7; const LAS unsigned* tp = tile + row * 33 + pc * 4;
            v4u ov; ov.x = tp[0]; ov.y = tp[1]; ov.z = tp[2]; ov.w = tp[3]; *(v4u*)((bf16*)(ws + WS_XBC) + (size_t)(k.row0 + row) * 768 + k.rmcol + pc * 8) = ov; }
    }
    if (k.tR >= 0) {
        bf16* frR = (bf16*)(ws + WS_FR) + ((size_t)k.cid * 46 + k.tR) * 8192;
#pragma unroll 4
        for (int q = 0; q < 8; ++q) { const int it = 8 * half + q, rt = it >> 2, ks = it & 3, r = lane & 31, hh = lane >> 5; const LAS unsigned* tp = tile + (32 * rt + r) * 33 + (2 * ks + hh) * 4;
            v4u ov; ov.x = tp[0]; ov.y = tp[1]; ov.z = tp[2]; ov.w = tp[3]; *(v4u*)(frR + (it * 64 + lane) * 8) = ov; }
    }
    if (k.tX >= 0) {
        bf16* frX = (bf16*)(ws + WS_FR) + ((size_t)k.cid * 46 + k.tX) * 8192;
#pragma unroll 2
        for (int q = 0; q < 8; ++q) {
            const int ct = q >> 2, i = 2 * half + ((q >> 1) & 1), kk = q & 1, it = (ct * 4 + i) * 2 + kk, r = lane & 31, hh = lane >> 5, col = 32 * ct + r, rb = 32 * i + 16 * kk + 4 * hh; unsigned e[8];
#pragma unroll
            for (int jj = 0; jj < 8; ++jj) { const unsigned wv = tile[(rb + 8 * (jj >> 2) + (jj & 3)) * 33 + (col >> 1)]; e[jj] = (col & 1) ? (wv >> 16) : (wv & 0xffffu); }
            v4u ov; ov.x = e[0] | (e[1] << 16); ov.y = e[2] | (e[3] << 16); ov.z = e[4] | (e[5] << 16); ov.w = e[6] | (e[7] << 16);
            *(v4u*)(frX + (it * 64 + lane) * 8) = ov; }
    }
}
DEVI void ph_tiles(const Args& A, LAS unsigned char* lds, const Wv& w0, int layer) {
    WV_LOCAL(w0);
    unsigned char* ws = A.ws; const bf16* P = (const bf16*)(ws + WS_P);
    LAS unsigned* tile = (LAS unsigned*)(lds + w.wave * 16896);
    LAS bf16* CW = (LAS bf16*)(lds + 8 * 16896);
    for (int i = w.tid; i < 6 * 768; i += NWAVES * 64) { const float v = i < 5 * 768 ? A.in[9][(size_t)layer * 5 * 768 + i] : A.in[10][layer * 768 + (i - 5 * 768)]; CW[i] = (bf16)f2bf(v); }
    __syncthreads();
    int c8 = w.lane & 7, rg = w.lane >> 3; const int NTASK = NCID * 36;
    TileTask pk = tiles_decode(0); bool pvalid = false;
    for (int task = w.gw; task < NTASK; task += w.NGW) {
        asm volatile("" : "+v"(c8), "+v"(rg));
        const TileTask k = tiles_decode(task);
        const bf16* src = P + (size_t)k.row0 * PW + k.srccol + c8 * 8;
#pragma unroll 1
        for (int half = 0; half < 2; ++half) {
            const int l0 = half * 64 + rg * 8;
            v4u o[8];
            if (k.conv) {
                v4u u[12];
#pragma unroll
                for (int i = 0; i < 12; ++i) { const int l = l0 - 2 + i, tt = k.ts0 + l; const bool ok = tt >= 0 && tt < k.L; const int lc = ok ? l : l0;
                    u[i] = *(const v4u*)(src + (ptrdiff_t)lc * PW); }
                asm volatile("" ::: "memory");
                if (pvalid) tiles_flush(ws, pk, half, tile, w.lane);
                LDS_WAIT(); asm volatile("" ::: "memory");
                float f[12][8], cwv[6][8];
#pragma unroll
                for (int q = 0; q < 6; ++q) { const v4u wq = *(const LAS v4u*)(CW + q * 768 + k.t * 64 + c8 * 8); unpack8(wq, cwv[q]); }
#pragma unroll
                for (int i = 0; i < 12; ++i) { const int tt = k.ts0 + l0 - 2 + i; v4u uu = u[i]; if (!(tt >= 0 && tt < k.L)) uu = (v4u){0u, 0u, 0u, 0u}; unpack8(uu, f[i]); }
#pragma unroll
                for (int i = 0; i < 8; ++i) { float acc[8];
#pragma unroll
                    for (int e = 0; e < 8; ++e) { float a = cwv[5][e];
#pragma unroll
                        for (int q = 0; q < 5; ++q) a += cwv[q][e] * f[i + q][e];
                        acc[e] = silu_f(a); }
                    o[i] = pack8(acc); }
            } else if (k.rope) {
                const bf16* srcp = P + (size_t)k.row0 * PW + k.srccol + (c8 ^ 4) * 8; const float sgn = c8 < 4 ? -1.0f : 1.0f; const int pv = c8 & 3;
                v4u u[8], up[8]; f32x4 ta[4], tdv[4];
#pragma unroll
                for (int i = 0; i < 8; ++i) { u[i] = *(const v4u*)(src + (size_t)(l0 + i) * PW); up[i] = *(const v4u*)(srcp + (size_t)(l0 + i) * PW); }
                { const int tq0 = k.ts0 + l0; const int pos0 = (k.cc < 2) ? 0 : ((pv < 2) ? (tq0 >> 6) : 128 + (tq0 & 63)), posd = (k.cc < 2 || pv < 2) ? 0 : 129;
                  const float* tb = (const float*)(ws + WS_ROPE) + ((size_t)pos0 * 16 + (pv & 1) * 8) * 2; const float* td = (const float*)(ws + WS_ROPE) + ((size_t)posd * 16 + (pv & 1) * 8) * 2;
#pragma unroll
                  for (int q = 0; q < 4; ++q) { ta[q] = *(const f32x4*)(tb + 4 * q); tdv[q] = *(const f32x4*)(td + 4 * q); } }
                asm volatile("" ::: "memory");
                if (pvalid) tiles_flush(ws, pk, half, tile, w.lane);
                LDS_WAIT(); asm volatile("" ::: "memory");
                float cb[8], sb[8], cd[8], sd[8];
#pragma unroll
                for (int e = 0; e < 8; e += 2) { const f32x4 a = ta[e >> 1], d = tdv[e >> 1]; cb[e] = a.x; sb[e] = a.y; cb[e + 1] = a.z; sb[e + 1] = a.w; cd[e] = d.x; sd[e] = d.y; cd[e + 1] = d.z; sd[e + 1] = d.w; }
#pragma unroll
                for (int i = 0; i < 8; ++i) { float own[8], pr[8], ov[8]; unpack8(u[i], own); unpack8(up[i], pr);
#pragma unroll
                    for (int e = 0; e < 8; ++e) { ov[e] = (own[e] * cb[e] + sgn * pr[e] * sb[e]) * k.scl; const float cn = cb[e] * cd[e] - sb[e] * sd[e], sn = sb[e] * cd[e] + cb[e] * sd[e]; cb[e] = cn; sb[e] = sn; }
                    o[i] = pack8(ov); }
            } else {
#pragma unroll
                for (int i = 0; i < 8; ++i) o[i] = *(const v4u*)(src + (size_t)(l0 + i) * PW);
                asm volatile("" ::: "memory");
                if (pvalid) tiles_flush(ws, pk, half, tile, w.lane);
                LDS_WAIT(); asm volatile("" ::: "memory");
            }
#pragma unroll
            for (int i = 0; i < 8; ++i) { LAS unsigned* tp = tile + (l0 + i) * 33 + c8 * 4; tp[0] = o[i].x; tp[1] = o[i].y; tp[2] = o[i].z; tp[3] = o[i].w; }
        }
        LDS_WAIT(); asm volatile("" ::: "memory");
        pk = k; pvalid = true;
    }
    if (pvalid) { tiles_flush(ws, pk, 0, tile, w.lane); tiles_flush(ws, pk, 1, tile, w.lane); }
    LDS_WAIT(); asm volatile("" ::: "memory");
}

DEVI void cum_setup(const Args& A, unsigned char* ws, int layer, int br, int h, int cid, int lane, LAS float* cs, float& decF, float& decB) {
    float af0, af1, ab0, ab1, tf0 = 1.f, tf1 = 1.f, tb0 = 1.f, tb1 = 1.f;
    if (br == 0) { const float* DTT = (const float*)(ws + WS_DTT) + ((size_t)cid * 16 + h) * 128 + 2 * lane; const float2 f = *(const float2*)DTT, bq = *(const float2*)(DTT + 8 * 128); tf0 = f.x; tf1 = f.y; tb0 = bq.x; tb1 = bq.y;
        const float Af = expf(A.in[12][layer * 16 + h]), Ab = expf(A.in[12][layer * 16 + 8 + h]); af0 = -tf0 * Af; af1 = -tf1 * Af; ab0 = -tb0 * Ab; ab1 = -tb1 * Ab; }
    else { const float lf = A.in[17][layer * 16 + h], lb = A.in[17][layer * 16 + 8 + h]; const float lgf = -log1pf(expf(-lf)), lgb = -log1pf(expf(-lb)); af0 = af1 = lgf; ab0 = ab1 = lgb; }
    float pf = af0 + af1, pb = ab0 + ab1;
#pragma unroll
    for (int o = 1; o < 64; o <<= 1) { const float t = __shfl_up(pf, o), u = __shfl_up(pb, o); if (lane >= o) { pf += t; pb += u; } }
    const float totf = __shfl(pf, 63), totb = __shfl(pb, 63);
    const float a0 = pf - af1, a1 = pf;
    const float r0 = totb - (pb - ab0 - ab1), r1 = totb - (pb - ab1);
    cs[2 * lane] = a0; cs[2 * lane + 1] = a1; cs[128 + 2 * lane] = r0; cs[128 + 2 * lane + 1] = r1;
    cs[256 + 2 * lane] = tf0; cs[256 + 2 * lane + 1] = tf1; cs[384 + 2 * lane] = tb0; cs[384 + 2 * lane + 1] = tb1;
    cs[512 + 2 * lane] = tf0 * __expf(totf - a0); cs[512 + 2 * lane + 1] = tf1 * __expf(totf - a1);
    cs[640 + 2 * lane] = tb0 * __expf(totb - r0); cs[640 + 2 * lane + 1] = tb1 * __expf(totb - r1);
    decF = __expf(totf); decB = __expf(totb);
    LDS_WAIT(); asm volatile("" ::: "memory");
}

DEVI void ph_states(const Args& A, LAS unsigned char* lds, const Wv& w0, int layer) {
    WV_LOCAL(w0);
    unsigned char* ws = A.ws; LAS float* cs = (LAS float*)(lds + w.wave * 16384);
    const int hh = w.lane >> 5;
    for (int task2 = w.gw; task2 < 4 * NCID * 8; task2 += w.NGW) {
        const int task = task2 >> 1, dir = task2 & 1;
        const int br = task / (NCID * 8), rem = task % (NCID * 8), cid = rem >> 3, h = rem & 7;
        const bf16* fr = (const bf16*)(ws + WS_FR) + (size_t)cid * 46 * 8192 + w.lane * 8;
        const bf16* xx = fr + (size_t)(br == 0 ? 6 + h : 38 + h) * 8192;
        const bf16* bx = fr + (size_t)(br == 0 ? 4 + (h >> 2) : 30 + h) * 8192;
        bf16x8 af[2][8], bfr[2][8];
#pragma unroll
        for (int t = 0; t < 2; ++t)
#pragma unroll
            for (int k = 0; k < 8; ++k) { af[t][k] = ld8(xx + (t * 8 + k) * 512); bfr[t][k] = ld8(bx + (t * 8 + k) * 512); }
        float decF, decB; cum_setup(A, ws, layer, br, h, cid, w.lane, cs, decF, decB);
        f32x16 acc[2][2];
#pragma unroll
        for (int a = 0; a < 2; ++a)
#pragma unroll
            for (int b = 0; b < 2; ++b)
#pragma unroll
                for (int i = 0; i < 16; ++i) acc[a][b][i] = 0.f;
        const LAS float* wv = cs + 512 + dir * 128 + 4 * hh;
#pragma unroll
        for (int k = 0; k < 8; ++k) {
            const f32x4 w0v = *(const LAS f32x4*)(wv + 16 * k), w1v = *(const LAS f32x4*)(wv + 16 * k + 8);
            bf16x8 aw[2];
#pragma unroll
            for (int pt = 0; pt < 2; ++pt) { float f[8]; unpack8(__builtin_bit_cast(v4u, af[pt][k]), f);
                f[0] *= w0v.x; f[1] *= w0v.y; f[2] *= w0v.z; f[3] *= w0v.w; f[4] *= w1v.x; f[5] *= w1v.y; f[6] *= w1v.z; f[7] *= w1v.w;
                aw[pt] = __builtin_bit_cast(bf16x8, pack8(f)); }
#pragma unroll
            for (int pt = 0; pt < 2; ++pt)
#pragma unroll
                for (int nt = 0; nt < 2; ++nt) acc[pt][nt] = MFMA32(aw[pt], bfr[nt][k], acc[pt][nt]);
        }
        const size_t idx = ((size_t)(br * 2 + dir) * NCID + cid) * 8 + h;
        unsigned* st = (unsigned*)(ws + WS_ST) + idx * 2048 + w.lane;
#pragma unroll
        for (int pt = 0; pt < 2; ++pt)
#pragma unroll
            for (int nt = 0; nt < 2; ++nt)
#pragma unroll
                for (int i2 = 0; i2 < 8; ++i2) st[((pt * 2 + nt) * 8 + i2) * 64] = pk2(acc[pt][nt][2 * i2], acc[pt][nt][2 * i2 + 1]);
        if (w.lane == 0) ((float*)(ws + WS_DEC))[idx] = dir ? decB : decF;
        LDS_WAIT(); asm volatile("" ::: "memory");
    }
}

DEVI void ph_scan(const Args& A, const Wv& w0) {
    WV_LOCAL(w0);
    unsigned char* ws = A.ws; const float* ST = (const float*)(ws + WS_ST); const float* DEC = (const float*)(ws + WS_DEC); bf16* PREV = (bf16*)(ws + WS_PREV);
    for (int gt = w.gw * 64 + w.lane; gt < 2 * 2 * NB * 8 * 1024; gt += w.NGW * 64) {
        const int half = gt & 1, lp = (gt >> 1) & 63, ks = (gt >> 7) & 3, pt = (gt >> 9) & 1, h = (gt >> 10) & 7, b = (gt >> 13) & 3, dir = (gt >> 15) & 1, br = gt >> 16;
        const int rp = lp & 31, hn = lp >> 5, hp = (rp >> 2) & 1, ri = (rp & 3) + 4 * (rp >> 3), n0 = 16 * ks + 8 * hn + 4 * half, nt = n0 >> 5, rn = n0 & 31;
        const int so = ((pt * 2 + nt) * 8 + (ri >> 1)) * 64 + hp * 32 + rn, po = ((pt * 4 + ks) * 64 + lp) * 8 + 4 * half; const bool odd = ri & 1;
        f32x4 s = {0.f, 0.f, 0.f, 0.f};
        v4u sw[6]; float dec[6]; size_t ix[6];
#pragma unroll
        for (int q = 0; q < 6; ++q) { const int k = q; const int c = dir == 0 ? k : (k == 0 ? 1 : (k == 1 ? 0 : NCH + 1 - k));
            ix[q] = ((size_t)(br * 2 + dir) * NCID + b * NCH + c) * 8 + h; sw[q] = *(const v4u*)((const unsigned*)ST + ix[q] * 2048 + so); dec[q] = DEC[ix[q]]; }
#pragma unroll 1
        for (int k0 = 0; k0 < NCH; k0 += 6) {
            f32x4 st[6]; float dc[6]; size_t ic[6];
#pragma unroll
            for (int q = 0; q < 6; ++q) { const v4u v = sw[q]; st[q] = odd ? (f32x4){bfh(v.x), bfh(v.y), bfh(v.z), bfh(v.w)} : (f32x4){bfl(v.x), bfl(v.y), bfl(v.z), bfl(v.w)}; dc[q] = dec[q]; ic[q] = ix[q]; }
            asm volatile("" ::: "memory");
            if (k0 + 6 < NCH) {
#pragma unroll
                for (int q = 0; q < 6; ++q) { const int k = k0 + 6 + q; const int c = dir == 0 ? k : (k == 0 ? 1 : (k == 1 ? 0 : NCH + 1 - k));
                    ix[q] = ((size_t)(br * 2 + dir) * NCID + b * NCH + c) * 8 + h; sw[q] = *(const v4u*)((const unsigned*)ST + ix[q] * 2048 + so); dec[q] = DEC[ix[q]]; } }
            asm volatile("" ::: "memory");
#pragma unroll
            for (int q = 0; q < 6; ++q) { v2u o; o.x = pk2(s.x, s.y); o.y = pk2(s.z, s.w); *(v2u*)(PREV + ic[q] * 4096 + po) = o; s = s * dc[q] + st[q]; }
        }
    }
}

DEVI void ph_outputs(const Args& A, LAS unsigned char* lds, const Wv& w0, int layer, bool skipctx) {
    WV_LOCAL(w0);
    unsigned char* ws = A.ws; LAS float* cs = (LAS float*)(lds + w.wave * 16384); LAS float* yt = cs + 1024;
    const int r = w.lane & 31, hh = w.lane >> 5;
    const bf16* P = (const bf16*)(ws + WS_P);
    for (int task4 = w.gw; task4 < 8 * NCID * 8; task4 += w.NGW) {
        const int task = task4 >> 2, j = task4 & 3;
        const int br = task / (NCID * 8), rem = task % (NCID * 8), cid = rem >> 3, h = rem & 7, row0 = chunk_row0(cid);
        if (skipctx && (cid % NCH) < 2) continue;
        const bf16* fr = (const bf16*)(ws + WS_FR) + (size_t)cid * 46 * 8192 + w.lane * 8;
        const bf16* cf = fr + (size_t)(br == 0 ? (h >> 2) : 14 + h) * 8192;
        const bf16* bf = fr + (size_t)(br == 0 ? 2 + (h >> 2) : 22 + h) * 8192;
        const bf16* xx = fr + (size_t)(br == 0 ? 6 + h : 38 + h) * 8192;
        const bf16* pvf = (const bf16*)(ws + WS_PREV) + (((size_t)(br * 2 + 0) * NCID + cid) * 8 + h) * 4096 + w.lane * 8;
        const bf16* pvb = pvf + (size_t)NCID * 8 * 4096;
        const int l = 32 * j + r;
        bf16x8 Cf[4], pF[2][4], pB[2][4], bA[4], xA[2][2];
#pragma unroll
        for (int ks = 0; ks < 4; ++ks) Cf[ks] = ld8(cf + (j * 4 + ks) * 512);
#pragma unroll
        for (int pt = 0; pt < 2; ++pt)
#pragma unroll
            for (int ks = 0; ks < 4; ++ks) { pF[pt][ks] = ld8(pvf + (pt * 4 + ks) * 512); pB[pt][ks] = ld8(pvb + (pt * 4 + ks) * 512); }
#pragma unroll
        for (int ks = 0; ks < 4; ++ks) bA[ks] = ld8(bf + ks * 512);
#pragma unroll
        for (int kk = 0; kk < 2; ++kk)
#pragma unroll
            for (int pt = 0; pt < 2; ++pt) xA[kk][pt] = ld8(xx + ((pt * 4) * 2 + kk) * 512);
        v4u ep0[4], ep1[4];
        { const int sgp = w.lane & 7;
#pragma unroll
          for (int k = 0; k < 4; ++k) { const size_t rowp = (size_t)(row0 + 32 * j + 8 * k + (w.lane >> 3));
            if (br == 0) { ep0[k] = *(const v4u*)((const bf16*)(ws + WS_XBC) + rowp * 768 + h * 64 + 8 * sgp); ep1[k] = *(const v4u*)(P + rowp * PW + PC_Z + h * 64 + 8 * sgp); }
            else { ep0[k] = *(const v4u*)(P + rowp * PW + PC_G + h * 64 + 8 * sgp); ep1[k] = ep0[k]; } } }
        float decF, decB; cum_setup(A, ws, layer, br, h, cid, w.lane, cs, decF, decB);
        const float acl = cs[l], racl = cs[128 + l]; const float ef = __expf(acl), eb = __expf(racl);
        f32x16 y[2];
#pragma unroll
        for (int pt = 0; pt < 2; ++pt) {
            f32x16 tf, tb;
#pragma unroll
            for (int i = 0; i < 16; ++i) { tf[i] = 0.f; tb[i] = 0.f; }
#pragma unroll
            for (int ks = 0; ks < 4; ++ks) { tf = MFMA32(pF[pt][ks], Cf[ks], tf); tb = MFMA32(pB[pt][ks], Cf[ks], tb); }
#pragma unroll
            for (int i = 0; i < 16; ++i) y[pt][i] = ef * tf[i] + eb * tb[i];
        }
#pragma unroll 1
        for (int i = 0; i < 4; ++i) {
            bf16x8 bN[4], xN[2][2];
            { const int in = i < 3 ? i + 1 : 3;
#pragma unroll
              for (int ks = 0; ks < 4; ++ks) bN[ks] = ld8(bf + (in * 4 + ks) * 512);
#pragma unroll
              for (int kk = 0; kk < 2; ++kk)
#pragma unroll
                for (int pt = 0; pt < 2; ++pt) xN[kk][pt] = ld8(xx + ((pt * 4 + in) * 2 + kk) * 512); }
            f32x16 g;
#pragma unroll
            for (int q = 0; q < 16; ++q) g[q] = 0.f;
#pragma unroll
            for (int ks = 0; ks < 4; ++ks) g = MFMA32(bA[ks], Cf[ks], g);
#pragma unroll
            for (int q4 = 0; q4 < 4; ++q4) {
                const int s0 = 32 * i + 8 * q4 + 4 * hh;
                f32x4 fac = {0.f, 0.f, 0.f, 0.f};
                if (i <= j) { const f32x4 as = *(const LAS f32x4*)(cs + s0), dt = *(const LAS f32x4*)(cs + 256 + s0);
#pragma unroll
                    for (int e = 0; e < 4; ++e) fac[e] += (s0 + e <= l) ? __expf(fminf(acl - as[e], 0.f)) * dt[e] : 0.f; }
                if (i >= j) { const f32x4 rs4 = *(const LAS f32x4*)(cs + 128 + s0), dt = *(const LAS f32x4*)(cs + 384 + s0);
#pragma unroll
                    for (int e = 0; e < 4; ++e) fac[e] += (s0 + e >= l) ? __expf(fminf(racl - rs4[e], 0.f)) * dt[e] : 0.f; }
#pragma unroll
                for (int e = 0; e < 4; ++e) g[q4 * 4 + e] *= fac[e];
            }
#pragma unroll
            for (int kk = 0; kk < 2; ++kk) {
                v4u mw; mw.x = pk2(g[8 * kk + 0], g[8 * kk + 1]); mw.y = pk2(g[8 * kk + 2], g[8 * kk + 3]); mw.z = pk2(g[8 * kk + 4], g[8 * kk + 5]); mw.w = pk2(g[8 * kk + 6], g[8 * kk + 7]);
                const bf16x8 Mf = __builtin_bit_cast(bf16x8, mw);
#pragma unroll
                for (int pt = 0; pt < 2; ++pt) y[pt] = MFMA32(xA[kk][pt], Mf, y[pt]);
            }
#pragma unroll
            for (int ks = 0; ks < 4; ++ks) bA[ks] = bN[ks];
#pragma unroll
            for (int kk = 0; kk < 2; ++kk)
#pragma unroll
                for (int pt = 0; pt < 2; ++pt) xA[kk][pt] = xN[kk][pt];
        }
#pragma unroll
        for (int pt = 0; pt < 2; ++pt)
#pragma unroll
            for (int q = 0; q < 4; ++q) *(LAS f32x4*)(yt + r * 68 + 32 * pt + 8 * q + 4 * hh) = (f32x4){y[pt][4 * q], y[pt][4 * q + 1], y[pt][4 * q + 2], y[pt][4 * q + 3]};
        LDS_WAIT(); asm volatile("" ::: "memory");
        const int sg = w.lane & 7;
        const float dsk = br == 0 ? A.in[13][layer * 8 + h] : 0.f;
#pragma unroll
        for (int k = 0; k < 4; ++k) {
            const int lr = 8 * k + (w.lane >> 3); const size_t row = (size_t)(row0 + 32 * j + lr);
            const f32x4 ya = *(const LAS f32x4*)(yt + lr * 68 + 8 * sg), yb = *(const LAS f32x4*)(yt + lr * 68 + 8 * sg + 4);
            float yv[8] = {ya.x, ya.y, ya.z, ya.w, yb.x, yb.y, yb.z, yb.w};
            if (br == 0) {
                float x[8], z[8]; unpack8(ep0[k], x); unpack8(ep1[k], z);
                const f32x4 n0 = *(const f32x4*)(A.in[14] + layer * 512 + h * 64 + 8 * sg), n1 = *(const f32x4*)(A.in[14] + layer * 512 + h * 64 + 8 * sg + 4);
                const float ng[8] = {n0.x, n0.y, n0.z, n0.w, n1.x, n1.y, n1.z, n1.w};
                float ssq = 0.f;
#pragma unroll
                for (int e = 0; e < 8; ++e) { const float v = (yv[e] + dsk * x[e]) * silu_f(z[e]); ssq += v * v; yv[e] = v * ng[e]; }
                ssq += __shfl_xor(ssq, 1); ssq += __shfl_xor(ssq, 2); ssq += __shfl_xor(ssq, 4);
                if (sg == 0) ((float*)(ws + WS_SSQ))[row * 8 + h] = ssq;
                *(v4u*)((bf16*)(ws + WS_ABR) + row * 512 + h * 64 + 8 * sg) = pack8(yv);
            } else {
                float gz[8]; unpack8(ep0[k], gz);
                float sm = 0.f;
#pragma unroll
                for (int e = 0; e < 8; ++e) sm += yv[e];
                sm += __shfl_xor(sm, 1); sm += __shfl_xor(sm, 2); sm += __shfl_xor(sm, 4); const float mu = sm * (1.0f / 64.0f); float qq = 0.f;
#pragma unroll
                for (int e = 0; e < 8; ++e) { yv[e] -= mu; qq += yv[e] * yv[e]; }
                qq += __shfl_xor(qq, 1); qq += __shfl_xor(qq, 2); qq += __shfl_xor(qq, 4); const float rstd = 1.0f / sqrtf(qq * (1.0f / 64.0f) + EPS);
#pragma unroll
                for (int e = 0; e < 8; ++e) yv[e] = yv[e] * rstd * silu_f(gz[e]);
                *(v4u*)((bf16*)(ws + WS_ABR) + (size_t)2 * T * 512 + row * 512 + h * 64 + 8 * sg) = pack8(yv);
            }
        }
        LDS_WAIT(); asm volatile("" ::: "memory");
    }
}

DEVI void ph_sum3(const Args& A, const Wv& w0, int row_start) {
    WV_LOCAL(w0);
    unsigned char* ws = A.ws; const bf16* YG = (const bf16*)(ws + WS_YG); unsigned char* M8 = ws + WS_ABF; float* SA2 = (float*)(ws + WS_SA2);
#pragma unroll 2
    for (int row = row_start + w.gw; row < T; row += w.NGW) {
        const bf16* yp = YG + (size_t)row * 3072 + w.lane * 16; float f[16];
        { float a[8], b[8], d[8]; unpack8(*(const v4u*)yp, a); unpack8(*(const v4u*)(yp + 1024), b); unpack8(*(const v4u*)(yp + 2048), d);
#pragma unroll
          for (int i = 0; i < 8; ++i) f[i] = (a[i] + b[i]) + d[i];
          unpack8(*(const v4u*)(yp + 8), a); unpack8(*(const v4u*)(yp + 1032), b); unpack8(*(const v4u*)(yp + 2056), d);
#pragma unroll
          for (int i = 0; i < 8; ++i) f[8 + i] = (a[i] + b[i]) + d[i]; }
        float am = 0.f;
#pragma unroll
        for (int i = 0; i < 16; ++i) am = fmaxf(am, fabsf(f[i]));
#pragma unroll
        for (int o = 1; o < 64; o <<= 1) am = fmaxf(am, __shfl_xor(am, o));
        const float inv = am > 0.f ? 127.0f / am : 0.f; unsigned o4[4];
#pragma unroll
        for (int d = 0; d < 4; ++d) { unsigned v = 0;
#pragma unroll
            for (int b = 0; b < 4; ++b) v |= ((unsigned)((int)rintf(f[d * 4 + b] * inv) & 255)) << (8 * b);
            o4[d] = v; }
        v4u ov; ov.x = o4[0]; ov.y = o4[1]; ov.z = o4[2]; ov.w = o4[3];
        *(v4u*)(M8 + (size_t)row * D + w.lane * 16) = ov;
        if (w.lane == 0) SA2[row] = am * (1.0f / 127.0f);
    }
}

DEVI void ph_count(const Args& A, LAS unsigned char* lds, const Wv& w0, int tile0) {
    WV_LOCAL(w0);
    unsigned char* ws = A.ws; const v4i* ROUTE = (const v4i*)(ws + WS_ROUTE); int* CNTT = (int*)(ws + WS_CNTT);
    LAS int* wt = (LAS int*)lds;
    for (int tile = tile0 + w.vcu; tile < 132; tile += w.G) {
        const int s = w.tid, row = tile * 256 + (s >> 1); const v4i rt = ROUTE[row]; const int e = (s & 1) ? rt.y : rt.x;
#pragma unroll
        for (int x = 0; x < 8; ++x) { const unsigned long long m = __ballot(e == x); if (w.lane == 0) wt[w.wave * 8 + x] = __popcll(m); }
        __syncthreads();
        if (w.tid < 8) { int c = 0;
#pragma unroll
            for (int q = 0; q < 8; ++q) c += wt[q * 8 + w.tid]; CNTT[tile * 8 + w.tid] = c; }
        __syncthreads();
    }
}
DEVI void ph_gather(const Args& A, LAS unsigned char* lds, const Wv& w0, int tile0) {
    WV_LOCAL(w0);
    unsigned char* ws = A.ws; const v4i* ROUTE = (const v4i*)(ws + WS_ROUTE); const int* CNTT = (const int*)(ws + WS_CNTT);
    int* SLOTI = (int*)(ws + WS_SLOT); int* INFO = (int*)(ws + WS_MOEINFO); const bf16* TOK = (const bf16*)(ws + WS_ABF); bf16* SORT = (bf16*)(ws + WS_SORT);
    LAS int* cn = (LAS int*)lds;
    LAS int* wt = cn + 1056;
    LAS int* dbase = wt + 64;
    LAS int* tot = dbase + 8;
    LAS int* dst = tot + 8;
    for (int unit = tile0 * 4 + w.vcu; unit < 528; unit += w.G) {
        const int tile = unit >> 2, quarter = unit & 3;
        for (int i = w.tid; i < 1056; i += 512) cn[i] = CNTT[i];
        __syncthreads();
        if (w.tid < 8) { int base = 0, tt = 0; for (int t = tile0; t < 132; ++t) { const int c = cn[t * 8 + w.tid]; if (t < tile) base += c; tt += c; } dbase[w.tid] = base; tot[w.tid] = tt; }
        __syncthreads();
        if (w.tid == 0) { int ps = 0; for (int e = 0; e < 8; ++e) { const int padded = (tot[e] + 255) & ~255; dbase[e] += ps; if (unit == tile0 * 4) INFO[e] = ps >> 8; ps += padded; } if (unit == tile0 * 4) INFO[8] = ps >> 8; }
        const int s = w.tid, row = tile * 256 + (s >> 1); const v4i rt = ROUTE[row]; const int e = (s & 1) ? rt.y : rt.x;
        int myr = 0;
#pragma unroll
        for (int x = 0; x < 8; ++x) { const unsigned long long m = __ballot(e == x); if (e == x) myr = __popcll(m & ((1ull << w.lane) - 1ull)); if (w.lane == 0) wt[w.wave * 8 + x] = __popcll(m); }
        __syncthreads();
        int rank = myr; for (int q = 0; q < w.wave; ++q) rank += wt[q * 8 + e];
        const int d = dbase[e] + rank; dst[s] = d;
        if ((s >> 7) == quarter) SLOTI[(size_t)row * 2 + (s & 1)] = d;
        __syncthreads();
#pragma unroll 4
        for (int j = 0; j < 16; ++j) { const int sl = quarter * 128 + w.wave * 16 + j, r2 = tile * 256 + (sl >> 1); const int dd = dst[sl];
            const v4u a = *(const v4u*)((const unsigned char*)TOK + (size_t)r2 * D + w.lane * 16);
            *(v4u*)((unsigned char*)SORT + (size_t)dd * D + w.lane * 16) = a;
            if (w.lane == 0) ((float*)(ws + WS_SAS))[dd] = ((const float*)(ws + WS_SA))[r2]; }
        __syncthreads();
    }
}

__global__ void __launch_bounds__(NWAVES * 64, 2) mixer_fwd(Args args) {
    extern __shared__ __attribute__((aligned(16))) unsigned char lds_raw[];
    LAS unsigned char* lds = (LAS unsigned char*)lds_raw;
    volatile LAS unsigned* MISC = (volatile LAS unsigned*)(lds + MISC_OFF);
    Wv w; w.tid = threadIdx.x; w.lane = w.tid & 63; w.wave = __builtin_amdgcn_readfirstlane(w.tid >> 6);
    w.G = gridDim.x; { const int bx = blockIdx.x; w.vcu = (w.G % 8 == 0) ? (bx % 8) * (w.G / 8) + bx / 8 : bx; }
    w.gw = w.vcu * NWAVES + w.wave; w.NGW = w.G * NWAVES;
    unsigned char* ws = args.ws;
    for (int u = w.tid; u < (LDS_BYTES - RING_BYTES) / 4; u += NWAVES * 64) ((LAS unsigned*)(lds + RING_BYTES))[u] = 0u;
    __syncthreads();
    XcdBarrier bar = xcd_barrier_post((unsigned*)(ws + WS_CTL) + CW_BAR, MISC + 8);
#define GRID_BAR() xcd_barrier(bar)
#define OPQ(x) asm volatile("" : "+s"(x))

    for (int rep = 0; rep < REP_PRO; ++rep) { ph_prologue(args, lds, w);
    GRID_BAR(); }

    bf16* ABF = (bf16*)(ws + WS_ABF); bf16* X = (bf16*)(ws + WS_X); const float* MOD = (const float*)(ws + WS_MOD);
    for (int layer = 0; layer < DEPTH; ++layer) {
        if (layer == 0) for (int rep = 0; rep < REP_QW; ++rep) ph_quant_w(args, lds, w);
        if (layer == 2) ph_norm<0, true, false, true>(args, w, layer, 1); else for (int rep = 0; rep < REP_N1; ++rep) ph_norm<0, false, false, true>(args, w, layer, 0, 0, layer == 0);
        GRID_BAR();
        { unsigned char* ws = args.ws; OPQ(ws); int Gl = w.G; OPQ(Gl); pg8::Gemm g{ABF, (const bf16*)(ws + WS_WIN + (size_t)layer * NP * 1024), T, NP, 512}; pg8::StaticOrder S; S.init(T, NP, Gl, (int)blockIdx.x);
          pg8::EpiStoreBf16i8<false> E{(bf16*)(ws + WS_P), PW, (const float*)(ws + WS_SA), (const float*)(ws + WS_SBW) + (size_t)layer * NP, 1 << 20, ws + WS_G8};
          for (int rep = 0; rep < REP_WIN; ++rep) { pg8::gemm_phase<pg8::EpiStoreBf16i8<false>, pg8::StaticOrder, true, true, true>(lds, g, S, E); if (rep + 1 < REP_WIN) GRID_BAR(); } }
        GRID_BAR();
        for (int rep = 0; rep < REP_PREP; ++rep) { for (int r2 = 0; r2 < REP_P2; ++r2) ph_prep2(args, w, layer); for (int r2 = 0; r2 < REP_TL; ++r2) ph_tiles(args, lds, w, layer);
        GRID_BAR(); }
        for (int rep = 0; rep < REP_ST; ++rep) { ph_states(args, lds, w, layer);
        GRID_BAR(); }
        for (int rep = 0; rep < REP_SC; ++rep) { ph_scan(args, w);
        GRID_BAR(); }
        const int pm0 = layer == DEPTH - 1 ? 4 : 0;
        for (int rep = 0; rep < REP_OUT; ++rep) { ph_outputs(args, lds, w, layer, pm0 != 0);
        GRID_BAR(); }
        { unsigned char* ws = args.ws; OPQ(ws); int Gl = w.G; OPQ(Gl); pg8::Gemm g{(const bf16*)(ws + WS_ABR), (const bf16*)(ws + WS_WBR) + (size_t)layer * 3 * D * 512, 3 * T, 3 * D, 512}; pg8::MergeOrder S; S.init(T - pm0 * 256, 3 * D, Gl, (int)blockIdx.x, pm0);
          pg8::EpiGate E{ws + WS_G8, (bf16*)(ws + WS_YG), (const float*)(ws + WS_SSQ)};
          for (int rep = 0; rep < REP_MRG; ++rep) { pg8::gemm_phase<pg8::EpiGate, pg8::MergeOrder, true, true>(lds, g, S, E); if (rep + 1 < REP_MRG) GRID_BAR(); } }
        GRID_BAR();
        for (int rep = 0; rep < REP_SUM3; ++rep) ph_sum3(args, w, pm0 * 256);
        GRID_BAR();
        { unsigned char* ws = args.ws; OPQ(ws); int Gl = w.G; OPQ(Gl); pg8::Gemm g{ABF, (const bf16*)(ws + WS_WOUT + (size_t)layer * D * D), T, D, 512}; pg8::StaticOrder S; S.init(T - pm0 * 256, D, Gl, (int)blockIdx.x, pm0);
          pg8::EpiResidI8<false> E{X, MOD + (size_t)layer * 5 * 6144 + 2048, (const float*)(ws + WS_SA2), (const float*)(ws + WS_SBO) + (size_t)layer * D, args.in[2], args.in[0] - (size_t)NCTX * D, layer == 0 ? 1 : 0};
          pg8::gemm_phase<pg8::EpiResidI8<false>, pg8::StaticOrder, true, true, true>(lds, g, S, E); }
        GRID_BAR();
        if ((layer & 1) == 0) {
            for (int rep = 0; rep < REP_N2; ++rep) ph_norm<1, false, false, true>(args, w, layer, 0);
            GRID_BAR();
            { unsigned char* ws = args.ws; OPQ(ws); int Gl = w.G; OPQ(Gl); pg8::Gemm g{ABF, (const bf16*)(ws + WS_W13 + (size_t)(layer >> 1) * 2 * FF * 1024), T, 2 * FF, 512}; pg8::StaticOrder S; S.init(T, 2 * FF, Gl, (int)blockIdx.x);
              pg8::EpiSwiGLUf8 E{ws + WS_ACT8, FF, 1 << 20, (const float*)(ws + WS_SA), (const float*)(ws + WS_SB13) + (size_t)(layer >> 1) * 2 * FF};
              for (int rep = 0; rep < REP_FFN1; ++rep) { pg8::gemm_phase<pg8::EpiSwiGLUf8, pg8::StaticOrder, true, true, true>(lds, g, S, E); if (rep + 1 < REP_FFN1) GRID_BAR(); } }
            GRID_BAR();
            { unsigned char* ws = args.ws; OPQ(ws); int Gl = w.G; OPQ(Gl); pg8::Gemm g{(const bf16*)(ws + WS_ACT8), (const bf16*)(ws + WS_W2 + (size_t)(layer >> 1) * D * FF), T, D, FF / 2}; pg8::StaticOrder S; S.init(T, D, Gl, (int)blockIdx.x);
              pg8::EpiResidI8<true> E{X, MOD + (size_t)layer * 5 * 6144 + 5120, (const float*)(ws + WS_SACT), (const float*)(ws + WS_SB2) + (size_t)(layer >> 1) * D, args.in[2], args.in[0], 0};
              pg8::gemm_phase<pg8::EpiResidI8<true>, pg8::StaticOrder, true, true, false, true>(lds, g, S, E); }
            GRID_BAR();
        } else {
            ph_norm<1, false, true, true>(args, w, layer, 0, pm0 * 256);
            GRID_BAR();
            for (int rep = 0; rep < REP_MOE; ++rep) {
            ph_count(args, lds, w, pm0);
            GRID_BAR();
            ph_gather(args, lds, w, pm0);
            GRID_BAR();
            pg8::MoeOrder S; { const int* INFO = (const int*)(ws + WS_MOEINFO);
#pragma unroll
                for (int j = 0; j < 9; ++j) S.ts[j] = __builtin_amdgcn_readfirstlane(INFO[j]);
                S.R = S.ts[8]; S.G = w.G; S.c = (int)blockIdx.x; }
            { unsigned char* ws = args.ws; OPQ(ws); S.NT = 28; pg8::Gemm g{(const bf16*)(ws + WS_SORT), (const bf16*)(ws + WS_M13 + (size_t)(layer >> 1) * NEXP * 2 * EFF * 1024), CAP, NEXP * 2 * EFF, 512};
              pg8::EpiSwiGLUf8 E{ws + WS_ACT8, EFF, 28, (const float*)(ws + WS_SAS), (const float*)(ws + WS_SBM) + (size_t)(layer >> 1) * NEXP * 2 * EFF};
              for (int rep = 0; rep < REP_GM1; ++rep) { pg8::gemm_phase<pg8::EpiSwiGLUf8, pg8::MoeOrder, true, true, true>(lds, g, S, E); if (rep + 1 < REP_GM1) GRID_BAR(); } }
            GRID_BAR();
            { unsigned char* ws = args.ws; OPQ(ws); S.NT = 4; pg8::Gemm g{(const bf16*)(ws + WS_ACT8), (const bf16*)(ws + WS_M2 + (size_t)(layer >> 1) * NEXP * D * EFF), CAP, NEXP * D, EFF / 2};
              pg8::EpiStoreBf16i8<true> E{(bf16*)(ws + WS_YB), D, (const float*)(ws + WS_SACT), (const float*)(ws + WS_SBM2) + (size_t)(layer >> 1) * NEXP * D, 4, nullptr};
              for (int rep = 0; rep < REP_GM2; ++rep) { pg8::gemm_phase<pg8::EpiStoreBf16i8<true>, pg8::MoeOrder, true, true, false, true>(lds, g, S, E); if (rep + 1 < REP_GM2) GRID_BAR(); } }
            GRID_BAR();
            }
        }
    }
    ph_norm<2, true, false>(args, w, 0, 3);
}

extern "C" void kernel_launch(void* const* d_in, const int* in_sizes, int n_in, void* d_out, int out_size, void* d_ws, size_t ws_size, hipStream_t stream) {
    static int grid = 0;
    if (grid == 0) {
        if (n_in != 26 || out_size != NB * SEQ * D || ws_size < WS_END) { fprintf(stderr, "kernel_launch: unexpected shapes (n_in %d, out %d, ws %zu, need %zu)\n", n_in, out_size, ws_size, (size_t)WS_END); grid = -1; return; }
        int dev = 0, cus = 0, per_cu = 0;
        if (hipGetDevice(&dev) != hipSuccess || hipDeviceGetAttribute(&cus, hipDeviceAttributeMultiprocessorCount, dev) != hipSuccess) { grid = -1; return; }
        if (hipFuncSetAttribute((const void*)mixer_fwd, hipFuncAttributeMaxDynamicSharedMemorySize, LDS_BYTES) != hipSuccess) { fprintf(stderr, "kernel_launch: hipFuncSetAttribute failed\n"); grid = -1; return; }
        if (hipOccupancyMaxActiveBlocksPerMultiprocessor(&per_cu, (const void*)mixer_fwd, NWAVES * 64, LDS_BYTES) != hipSuccess || per_cu < 1)
            fprintf(stderr, "kernel_launch: occupancy query reports %d workgroups per CU\n", per_cu);
        (void)hipGetLastError();
        grid = cus;
    }
    if (grid < 0) return;
    if (hipMemsetAsync((char*)d_ws + WS_CTL, 0, CTL_ZERO_BYTES, stream) != hipSuccess) return;
    Args a{};
    for (int i = 0; i < 26; ++i) a.in[i] = (const float*)d_in[i];
    a.out = (float*)d_out; a.ws = (unsigned char*)d_ws;
    hipLaunchKernelGGL(mixer_fwd, dim3(grid), dim3(NWAVES * 64), LDS_BYTES, stream, a);
}
```
